# Optimizing an MI355X kernel written in HIP

```python
import jax, jax.numpy as jnp
from jax import lax
import numpy as np

D_MODEL = 2048
BATCH = 4
SEQ = 2048
DEPTH = 1
DEC_BATCH = 128
DEC_SEQ = 1
PAST_LEN = 16384
PAGE_SIZE = 128

A_W = 1024
A_GROUPS = 8
A_GROUP_W = A_W // A_GROUPS
CHUNK = 128
B_HEADS = 32
HEAD_SIZE = 64
B_W = B_HEADS * HEAD_SIZE
DECAY_LORA = 96
AAA_LORA = 96
SHIFT_W = 3 * B_W + DECAY_LORA + AAA_LORA
IN_SIZES = (A_W, A_W, A_W, SHIFT_W, B_W, D_MODEL, D_MODEL)
SHIFT_SIZES = (B_W, DECAY_LORA, B_W, B_W, AAA_LORA)
IN_W = 3 * A_W + SHIFT_W + B_W + 2 * D_MODEL
NORM_EPS = 1e-6
GN_EPS = HEAD_SIZE * 1e-5

kernel_name = "hybrid_gmlp_rwkv7_gated_step"


def _split(t, sizes):
    out, o = [], 0
    for s in sizes:
        out.append(t[..., o:o + s])
        o += s
    return out


def _rmsnorm(x, g):
    xf = x.astype(jnp.float32)
    y = xf * lax.rsqrt(jnp.mean(xf * xf, axis=-1, keepdims=True) + NORM_EPS)
    return (y * g.astype(jnp.float32)).astype(x.dtype)


def _layernorm(x, g, b):
    xf = x.astype(jnp.float32)
    mu = jnp.mean(xf, axis=-1, keepdims=True)
    var = jnp.mean(jnp.square(xf - mu), axis=-1, keepdims=True)
    y = (xf - mu) * lax.rsqrt(var + NORM_EPS)
    return (y * g.astype(jnp.float32) + b.astype(jnp.float32)).astype(x.dtype)


def _chunk_mix(v, w_s, b_s):
    bsz, T, _ = v.shape
    n_chunks = -(-T // CHUNK)
    tp = n_chunks * CHUNK
    vp = jnp.pad(v, ((0, 0), (0, tp - T), (0, 0)))
    vp = vp.reshape(bsz, n_chunks, CHUNK, A_GROUPS, A_GROUP_W)
    causal = jnp.tril(jnp.ones((CHUNK, CHUNK), dtype=bool))
    wm = jnp.where(causal[None], w_s, 0)
    out = jnp.einsum('gts,bnsgc->bntgc', wm, vp) + b_s.T[None, None, :, :, None]
    return out.reshape(bsz, tp, A_W)[:, :T]


def _wkv_scan(s0, r, w, k, v, a, b):
    def step(s, inp):
        r_t, w_t, k_t, v_t, a_t, b_t = inp
        sa = jnp.einsum('bhij,bhj->bhi', s, a_t)
        s = s * w_t[:, :, None, :] + sa[..., None] * b_t[:, :, None, :] + v_t[..., None] * k_t[:, :, None, :]
        y_t = jnp.einsum('bhij,bhj->bhi', s, r_t)
        return s, y_t
    xs = tuple(jnp.swapaxes(t.astype(jnp.float32), 0, 1) for t in (r, w, k, v, a, b))
    s, ys = lax.scan(step, s0.astype(jnp.float32), xs)
    return s, jnp.swapaxes(ys, 0, 1)


def _layer(x, c, wkv0, shift0, norm_g, w_c, b_c, w_in, ln_v_g, ln_v_b, w_s, b_s,
           mu_shift, w0, w2, a0, a2, k_k, k_a, r_k, gn_g, gn_b, p_a, p_b, w_out):
    bsz, T, _ = x.shape
    f32 = jnp.float32
    mod = c @ w_c + b_c
    c_shift, c_scale, c_gate = jnp.split(mod, 3, axis=-1)
    h = _rmsnorm(x, norm_g) * (1 + c_scale[:, None]) + c_shift[:, None]
    proj = jnp.einsum('btd,de->bte', h, w_in)
    u_a, v_a, z_a, p_rwkv, z_b, g_a, g_b = _split(proj, IN_SIZES)

    u = jax.nn.gelu(u_a)
    v = _layernorm(jax.nn.gelu(v_a), ln_v_g, ln_v_b)
    y_a = u * _chunk_mix(v, w_s, b_s) * jax.nn.silu(z_a)

    prev = jnp.concatenate([shift0[:, None].astype(p_rwkv.dtype), p_rwkv[:, :-1]], axis=1)
    ps = p_rwkv + mu_shift * (prev - p_rwkv)
    r, wd, k, vv, ad = _split(ps, SHIFT_SIZES)
    w_log = -jax.nn.softplus(-(w0 + jnp.tanh(wd) @ w2).astype(f32)) - 0.5
    decay = jnp.exp(-jnp.exp(w_log))
    a = jax.nn.sigmoid((a0 + ad @ a2).astype(f32))
    kk = (k * k_k).astype(f32).reshape(bsz, T, B_HEADS, HEAD_SIZE)
    kk = kk / jnp.maximum(jnp.linalg.norm(kk, axis=-1, keepdims=True), 1e-12)
    k = k.astype(f32) * (1 + (a - 1) * k_a.astype(f32))
    hd = lambda t: t.astype(f32).reshape(bsz, T, B_HEADS, HEAD_SIZE)
    r_h, w_h, k_h, v_h, a_h = hd(r), hd(decay), hd(k), hd(vv), hd(a)
    s_new, y = _wkv_scan(wkv0, r_h, w_h, k_h, v_h, -kk, kk * a_h)
    mu = jnp.mean(y, axis=-1, keepdims=True)
    var = jnp.mean(jnp.square(y - mu), axis=-1, keepdims=True)
    y = (y - mu) * lax.rsqrt(var + GN_EPS)
    y = y * gn_g.astype(f32).reshape(B_HEADS, HEAD_SIZE) + gn_b.astype(f32).reshape(B_HEADS, HEAD_SIZE)
    bonus = jnp.sum(r_h * k_h * r_k.astype(f32), axis=-1, keepdims=True) * v_h
    y_b = (y + bonus).reshape(bsz, T, B_W).astype(x.dtype) * jax.nn.silu(z_b)

    merged = jax.nn.sigmoid(g_a) * (y_a @ p_a) + jax.nn.sigmoid(g_b) * (y_b @ p_b)
    out = x + c_gate[:, None] * (merged @ w_out)
    return out, s_new, p_rwkv[:, -1], v


def setup_inputs(seed: int = 0) -> dict:
    key = jax.random.key(seed)
    ks = jax.random.split(key, 40)
    n = lambda i, shape: jax.random.normal(ks[i], shape, jnp.float32)
    L = DEPTH
    return {
        "x_prompt": n(0, (BATCH, SEQ, D_MODEL)),
        "x_sample": n(1, (DEC_BATCH, DEC_SEQ, D_MODEL)),
        "c_prompt": n(2, (BATCH, D_MODEL)),
        "c_sample": n(3, (DEC_BATCH, D_MODEL)),
        "state_wkv": 0.1 * n(4, (L, DEC_BATCH, B_HEADS, HEAD_SIZE, HEAD_SIZE)),
        "state_shift": n(5, (L, DEC_BATCH, SHIFT_W)),
        "norm_g": 1.0 + 0.02 * n(6, (L, D_MODEL)),
        "w_c": 0.5 * D_MODEL ** -0.5 * n(7, (L, D_MODEL, 3 * D_MODEL)),
        "b_c": 0.02 * n(8, (L, 3 * D_MODEL)),
        "w_in": D_MODEL ** -0.5 * n(9, (L, D_MODEL, IN_W)),
        "ln_v_g": 1.0 + 0.02 * n(10, (L, A_W)),
        "ln_v_b": 0.02 * n(11, (L, A_W)),
        "w_s": CHUNK ** -0.5 * n(12, (L, A_GROUPS, CHUNK, CHUNK)),
        "b_s": 1.0 + 0.1 * n(13, (L, A_GROUPS, CHUNK)),
        "mu_shift": jax.random.uniform(ks[14], (L, SHIFT_W), jnp.float32),
        "w0": jax.random.uniform(ks[15], (L, B_W), jnp.float32, -4.0, 1.0),
        "w2": 0.1 * DECAY_LORA ** -0.5 * n(16, (L, DECAY_LORA, B_W)),
        "a0": 0.1 * n(17, (L, B_W)),
        "a2": 0.1 * AAA_LORA ** -0.5 * n(18, (L, AAA_LORA, B_W)),
        "k_k": 0.85 + 0.05 * n(19, (L, B_W)),
        "k_a": 1.0 + 0.05 * n(20, (L, B_W)),
        "r_k": 0.1 * n(21, (L, B_HEADS, HEAD_SIZE)),
        "gn_g": 1.0 + 0.02 * n(22, (L, B_W)),
        "gn_b": 0.02 * n(23, (L, B_W)),
        "p_a": A_W ** -0.5 * n(24, (L, A_W, D_MODEL)),
        "p_b": B_W ** -0.5 * n(25, (L, B_W, D_MODEL)),
        "w_out": D_MODEL ** -0.5 * n(26, (L, D_MODEL, D_MODEL)),
        "final_g": 1.0 + 0.02 * n(27, (D_MODEL,)),
    }


def reference(x_prompt, x_sample, c_prompt, c_sample, state_wkv, state_shift,
              norm_g, w_c, b_c, w_in, ln_v_g, ln_v_b, w_s, b_s,
              mu_shift, w0, w2, a0, a2, k_k, k_a, r_k, gn_g, gn_b,
              p_a, p_b, w_out, final_g):
    bp = x_prompt.shape[0]
    wkv_zero = jnp.zeros((bp, B_HEADS, HEAD_SIZE, HEAD_SIZE), jnp.float32)
    shift_zero = jnp.zeros((bp, SHIFT_W), x_prompt.dtype)
    hp, hs = x_prompt, x_sample
    wkv_p, sh_p, wkv_s, sh_s, cv_s = [], [], [], [], []
    for l in range(DEPTH):
        params = (norm_g[l], w_c[l], b_c[l], w_in[l], ln_v_g[l], ln_v_b[l], w_s[l], b_s[l],
                  mu_shift[l], w0[l], w2[l], a0[l], a2[l], k_k[l], k_a[l], r_k[l],
                  gn_g[l], gn_b[l], p_a[l], p_b[l], w_out[l])
        hp, s_p, shp, _ = _layer(hp, c_prompt, wkv_zero, shift_zero, *params)
        hs, s_s, shs, v_s = _layer(hs, c_sample, state_wkv[l], state_shift[l], *params)
        wkv_p.append(s_p); sh_p.append(shp)
        wkv_s.append(s_s); sh_s.append(shs); cv_s.append(v_s)
    y_prompt = _rmsnorm(hp, final_g)
    y_sample = _rmsnorm(hs, final_g)
    wkv_prompt = jnp.stack(wkv_p)
    shift_prompt = jnp.stack(sh_p)
    wkv_sample = jnp.stack(wkv_s)
    shift_sample = jnp.stack(sh_s)
    chunk_v_sample = jnp.stack(cv_s)
    return (y_prompt, y_sample, wkv_prompt, shift_prompt, wkv_sample, shift_sample, chunk_v_sample)
```

```cpp
#include <hip/hip_runtime.h>
#include <cstdio>

#ifndef REP_MASK
#define REP_MASK 0
#endif
#define REP(n) for (int rep_ = 0; rep_ < (((REP_MASK >> (n)) & 1) ? 2 : 1); ++rep_)
#ifndef N_LAUNCH_PER_PHASE
#define N_LAUNCH_PER_PHASE 0
#endif

#define LAS __attribute__((address_space(3)))
typedef unsigned short bf16_t;
typedef short bf16x8 __attribute__((ext_vector_type(8)));
typedef float f32x4 __attribute__((ext_vector_type(4)));
typedef float f32x2 __attribute__((ext_vector_type(2)));
typedef unsigned u32x4 __attribute__((ext_vector_type(4)));
typedef unsigned u32x2 __attribute__((ext_vector_type(2)));

constexpr int D = 2048, NTOK_P = 8192, NTOK_S = 128, NTOK = 8320, MP = 8448, SEQ = 2048;
constexpr int A_W = 1024, B_W = 2048, SHIFT_W = 6336, IN_W = 15552;
constexpr int LDP = 15616;
constexpr int C_UA = 0, C_VA = 1024, C_ZA = 2048, C_PR = 3072, C_ZB = 9472, C_GA = 11520, C_GB = 13568;
constexpr int PR_R = 0, PR_WD = 2048, PR_K = 2144, PR_V = 4192, PR_AD = 6240;
constexpr int NMODROW = 132, XCD_BAR_WORDS_C = 3456;

constexpr size_t SZ_WTIN = (size_t)LDP * D * 2, SZ_H = (size_t)MP * D * 2;
constexpr size_t WS_WTIN = 0, WS_H = WS_WTIN + SZ_WTIN;
constexpr size_t WS_E = 0, WS_AAA = WS_E + (size_t)NTOK * D * 2, WS_YA = WS_AAA + (size_t)NTOK * D * 2, WS_YB = 0;
constexpr size_t WS_PROJ = WS_H + SZ_H, SZ_PROJ = (size_t)MP * LDP * 2;
constexpr size_t WS_WTPA = WS_PROJ + SZ_PROJ, WS_WTPB = WS_WTPA + (size_t)D * A_W * 2, WS_WTOUT = WS_WTPB + (size_t)D * B_W * 2;
constexpr size_t WS_W2T = WS_WTOUT + (size_t)D * D * 2, WS_A2T = WS_W2T + (size_t)B_W * 96 * 2;
constexpr size_t WS_MOD = WS_A2T + (size_t)B_W * 96 * 2, WS_C = WS_MOD + (size_t)NMODROW * 6144 * 4;
constexpr size_t WS_Y = WS_C + (size_t)NTOK_P * 32 * 4, WS_MRG = WS_Y + (size_t)NTOK_P * D * 4, WS_ES = WS_MRG + SZ_H, WS_BAR = WS_ES + (size_t)NTOK_S * D * 2, WS_END = WS_BAR + XCD_BAR_WORDS_C * 4;
static_assert(WS_YA + (size_t)MP * A_W * 2 <= WS_PROJ, "alias region overflow");

constexpr size_t O_Y = 0, O_WKVP = (size_t)NTOK * D, O_SHP = O_WKVP + 4 * 32 * 4096, O_WKVS = O_SHP + 4 * SHIFT_W, O_SHS = O_WKVS + (size_t)128 * 32 * 4096,
                 O_CV = O_SHS + (size_t)128 * SHIFT_W;

struct P {
    const float* in[28];
    float* out;
    unsigned char* ws;
    int ph_lo, ph_hi;
};
typedef const __attribute__((address_space(4))) P* PP;
enum { I_XP = 0, I_XS, I_CP, I_CS, I_SWKV, I_SSH, I_NORMG, I_WC, I_BC, I_WIN, I_LNG, I_LNB, I_WS, I_BS, I_MU, I_W0, I_W2, I_A0, I_A2, I_KK, I_KA, I_RK, I_GNG, I_GNB,
       I_PA, I_PB, I_WOUT, I_FG };

typedef __bf16 bf16x2_t __attribute__((ext_vector_type(2)));
__device__ __forceinline__ unsigned cvt_pk_bf16(float lo, float hi) { const f32x2 v = {lo, hi}; const bf16x2_t b = __builtin_convertvector(v, bf16x2_t); return __builtin_bit_cast(unsigned, b); }
__device__ __forceinline__ bf16_t f2bf(float f) { return (bf16_t)(cvt_pk_bf16(f, 0.f) & 0xffffu); }
__device__ __forceinline__ float bf2f(bf16_t b) { return __uint_as_float(((unsigned)b) << 16); }
__device__ __forceinline__ float bflo(unsigned u) { return __uint_as_float(u << 16); }
__device__ __forceinline__ float bfhi(unsigned u) { return __uint_as_float(u & 0xffff0000u); }
__device__ __forceinline__ int tid_opaque() { int t = threadIdx.x; asm volatile("" : "+v"(t)); return t; }
__device__ __forceinline__ float wave_sum(float v) {
    v += __shfl_xor(v, 32); v += __shfl_xor(v, 16); v += __shfl_xor(v, 8); v += __shfl_xor(v, 4); v += __shfl_xor(v, 2); v += __shfl_xor(v, 1); return v;
}
template <int CTRL> __device__ __forceinline__ float dppf(float x) { return __int_as_float(__builtin_amdgcn_update_dpp(0, __float_as_int(x), CTRL, 0xf, 0xf, false)); }
__device__ __forceinline__ float red8(float x) { x += dppf<0xB1>(x); x += dppf<0x4E>(x); x += dppf<0x141>(x); return x; }
__device__ __forceinline__ float sigmoid_f(float x) { return __builtin_amdgcn_rcpf(1.f + __builtin_amdgcn_exp2f(-1.4426950408889634f * x)); }
__device__ __forceinline__ float tanh_fast(float x) { return 1.f - 2.f * __builtin_amdgcn_rcpf(1.f + __builtin_amdgcn_exp2f(2.8853900817779268f * x)); }
__device__ __forceinline__ float gelu_tanh_f(float x) { return x * sigmoid_f(1.5957691216057308f * (x + 0.044715f * x * x * x)); }
__device__ __forceinline__ float silu_f(float x) { return x * sigmoid_f(x); }
__device__ __forceinline__ void unpack8(const u32x4 r, float (&f)[8]) {
    f[0] = bflo(r[0]); f[1] = bfhi(r[0]); f[2] = bflo(r[1]); f[3] = bfhi(r[1]); f[4] = bflo(r[2]); f[5] = bfhi(r[2]); f[6] = bflo(r[3]); f[7] = bfhi(r[3]);
}
__device__ __forceinline__ u32x4 pack8(const float (&f)[8]) { u32x4 r; r[0] = cvt_pk_bf16(f[0], f[1]); r[1] = cvt_pk_bf16(f[2], f[3]); r[2] = cvt_pk_bf16(f[4], f[5]); r[3] = cvt_pk_bf16(f[6], f[7]); return r; }


#define XB_TMO      128
#define XB_XCNT(j)  (256  + 64 * (j))
#define XB_XSUB(j)  (1280 + 64 * (j))
#define XB_XGEN(j)  (2304 + 64 * (j))
#define XB_TOP      3328
#define XB_TOPGEN   3392
#define XCD_BAR_WORDS 3456
#define XB_SPIN_CAP (1u << 18)
__device__ __forceinline__ unsigned xb_ld(unsigned* p)              { return __hip_atomic_load(p, __ATOMIC_RELAXED, __HIP_MEMORY_SCOPE_AGENT); }
__device__ __forceinline__ unsigned xb_add(unsigned* p, unsigned v) { return __hip_atomic_fetch_add(p, v, __ATOMIC_RELAXED, __HIP_MEMORY_SCOPE_AGENT); }
__device__ __forceinline__ unsigned xb_xcc_id() { return (unsigned)__builtin_amdgcn_s_getreg((3 << 11) | 20) & 0xFu; }
#define XB_SPIN(cond, bar) do { unsigned _sp = 0; while (cond) { __builtin_amdgcn_s_sleep(1); \
    if ((++_sp & 255u) == 0u) { if (xb_ld(&(bar)[XB_TMO])) break; if (_sp > XB_SPIN_CAP) { atomicAdd(&(bar)[XB_TMO], 1u); break; } } } } while (0)
struct XcdBarrier { unsigned* bar; unsigned x; volatile LAS unsigned* st; };
__device__ __forceinline__ XcdBarrier xcd_barrier_post(unsigned* bar, volatile LAS unsigned* st) {
    XcdBarrier b; b.bar = bar; b.x = xb_xcc_id(); b.st = st;
    if (threadIdx.x == 0) (void)xb_add(&bar[XB_XCNT(b.x)], 1u);
    return b;
}
__device__ __forceinline__ void xcd_barrier_complete(unsigned* bar, unsigned x, unsigned& nloc, unsigned& nx) {
    const unsigned G = gridDim.x * gridDim.y * gridDim.z;
    unsigned sum, cnt, mine, sp = 0u;
    for (;;) {
        sum = 0u; cnt = 0u; mine = 0u;
#pragma unroll
        for (unsigned j = 0; j < 16; ++j) { const unsigned c = xb_ld(&bar[XB_XCNT(j)]); sum += c; cnt += (c > 0u) ? 1u : 0u; mine = (j == x) ? c : mine; }
        if (sum == G) break;
        __builtin_amdgcn_s_sleep(1);
        if ((++sp & 255u) == 0u) { if (xb_ld(&bar[XB_TMO])) break; if (sp > XB_SPIN_CAP) { atomicAdd(&bar[XB_TMO], 1u); break; } }
    }
    nloc = mine > 0u ? mine : 1u; nx = cnt > 0u ? cnt : 1u;
}
__device__ __forceinline__ void xcd_barrier(const XcdBarrier& b) {
    asm volatile("s_waitcnt vmcnt(0)" ::: "memory");
    __syncthreads();
    if (threadIdx.x == 0) {
        unsigned* bar = b.bar;
        __builtin_amdgcn_s_waitcnt(0);
        unsigned nloc = b.st[0], nx = b.st[1];
        if (nloc == 0u) { xcd_barrier_complete(bar, b.x, nloc, nx); b.st[0] = nloc; b.st[1] = nx; }
        const unsigned old = xb_add(&bar[XB_XSUB(b.x)], 1u);
        const unsigned gen = old / nloc;
        if (old + 1u == (gen + 1u) * nloc) {
            __builtin_amdgcn_fence(__ATOMIC_RELEASE, "agent");
            asm volatile("s_waitcnt vmcnt(0)" ::: "memory");
            const unsigned og = xb_add(&bar[XB_TOP], 1u);
            const unsigned tg = og / nx;
            if (og + 1u == (tg + 1u) * nx) xb_add(&bar[XB_TOPGEN], 1u);
            else XB_SPIN(xb_ld(&bar[XB_TOPGEN]) == tg, bar);
            __builtin_amdgcn_fence(__ATOMIC_ACQUIRE, "agent");
            xb_add(&bar[XB_XGEN(b.x)], 1u);
            asm volatile("s_waitcnt vmcnt(0)" ::: "memory");
        } else {
            XB_SPIN(xb_ld(&bar[XB_XGEN(b.x)]) == gen, bar);
            __builtin_amdgcn_fence(__ATOMIC_ACQUIRE, "agent");
            asm volatile("s_waitcnt vmcnt(0)" ::: "memory");
        }
    }
    __syncthreads();
}

namespace pg8 {
constexpr int BM = 256, BK = 64, HALF = 128, HTB = HALF * BK * 2, STAGE_BYTES = 8 * HTB, NXCD = 8, WGM = 2;
__device__ __forceinline__ int lds_byte(int r, int c) { const int st = (r >> 4) * 2 + (c >> 5), rr = r & 15, cc = c & 31, ob = rr * 64 + cc * 2; return st * 1024 + (ob ^ (((ob >> 9) & 1) << 5)); }
__device__ __forceinline__ void stage_rc(int b, int& R, int& C) { const int st = b / 1024, sb = b % 1024, swz = sb ^ (((sb >> 9) & 1) << 5); R = (st >> 1) * 16 + swz / 64; C = (st & 1) * 32 + (swz % 64) / 2; }
__device__ __forceinline__ int perm32(int rho) { const int n = rho >> 4, i = rho & 15; return 8 * (i >> 2) + 4 * n + (i & 3); }
struct Unit { int pm, pn; };
struct Gemm { const bf16_t* A; const bf16_t* Bt; int M, N, K; };
struct StaticOrder {
    int nM, nN, nwg, G, c;
    __device__ void init(int M, int N, int G_, int c_) { nM = M / BM; nN = N / BM; nwg = nM * nN; G = G_; c = c_; }
    __device__ bool next(int i, Unit& u) const {
        const long L = (long)i * G + c; if (L >= nwg) return false;
        int wgid = (int)L; { const int q = nwg / NXCD, r = nwg % NXCD, xcd = wgid % NXCD, off = wgid / NXCD; wgid = (xcd < r ? xcd * (q + 1) : r * (q + 1) + (xcd - r) * q) + off; }
        const int nig = WGM * nN, gid = wgid / nig, fm = gid * WGM, gsz = (nM - fm) < WGM ? (nM - fm) : WGM;
        u.pm = fm + ((wgid % nig) % gsz); u.pn = (wgid % nig) / gsz; return true;
    }
};

template <class Epi>
__device__ __forceinline__ void gemm_phase(LAS unsigned char* lds, const Gemm g, const StaticOrder& S, const Epi& E) {
    const int tid = tid_opaque(), wid = __builtin_amdgcn_readfirstlane(tid >> 6), lane = tid & 63, wr = wid >> 2, wc = wid & 3, fr = lane & 15, fq = lane >> 4;
    const int K = g.K, nt = K / BK;
    unsigned voffA[2], voffB[2];
#pragma unroll
    for (int i = 0; i < 2; ++i) { int R, C; stage_rc(tid * 16 + i * 8192, R, C); const int Rb = Epi::PERM ? ((R & ~31) + perm32(R & 31)) : R;
        voffA[i] = (unsigned)(R * K + C) * 2u; voffB[i] = (unsigned)(Rb * K + C) * 2u; }
    const size_t kstep = (size_t)(BK * 2);
    const size_t hstep = (size_t)HALF * K * 2;
    const size_t tstep = 2 * hstep;
    const unsigned ldsw = (unsigned)wid * 1024u;
    const int aoff = lds_byte(wr * 64 + fr, fq * 8), boff = lds_byte(wc * 32 + fr, fq * 8);
#define PG8_SA(b, h) (((b) * 2 + (h)) * HTB)
#define PG8_SB(b, h) ((4 + (b) * 2 + (h)) * HTB)
#define PG8_STAGE(bufoff, gbase, voff) do { _Pragma("unroll") for (int _i = 0; _i < 2; ++_i) \
        __builtin_amdgcn_global_load_lds((const unsigned*)((const char*)(gbase) + (voff)[_i]), (LAS unsigned*)(lds + (bufoff) + ldsw + _i * 8192), 16, 0, 0); } while (0)
#define PG8_LDA(dst, b, h) do { _Pragma("unroll") for (int m = 0; m < 4; ++m) _Pragma("unroll") for (int k = 0; k < 2; ++k) dst[m][k] = *(const LAS bf16x8*)(lds + PG8_SA(b, h) + aoff + m * 2048 + k * 1024); } while (0)
#define PG8_LDB(dst, b, h) do { _Pragma("unroll") for (int n = 0; n < 2; ++n) _Pragma("unroll") for (int k = 0; k < 2; ++k) dst[n][k] = *(const LAS bf16x8*)(lds + PG8_SB(b, h) + boff + n * 2048 + k * 1024); } while (0)
#define PG8_MMA(ai, bj, At, Bt) do { __builtin_amdgcn_s_setprio(1); _Pragma("unroll") for (int m = 0; m < 4; ++m) _Pragma("unroll") for (int n = 0; n < 2; ++n) _Pragma("unroll") for (int k = 0; k < 2; ++k) \
        acc[ai][bj][m][n] = __builtin_amdgcn_mfma_f32_16x16x32_bf16(Bt[n][k], At[m][k], acc[ai][bj][m][n], 0, 0, 0); __builtin_amdgcn_s_setprio(0); } while (0)
#define PG8_WAIT_V(n) asm volatile("s_waitcnt vmcnt(" #n ")" ::: "memory")
#define PG8_WAIT_L(n) asm volatile("s_waitcnt lgkmcnt(" #n ")" ::: "memory")
#define PG8_BAR __builtin_amdgcn_s_barrier()
#define PG8_SCHED __builtin_amdgcn_sched_barrier(0)
    Unit cur, nxt; int ui = 0;
    if (!S.next(0, cur)) return;
    f32x4 acc[2][2][4][2];
#pragma unroll
    for (int a = 0; a < 2; ++a)
#pragma unroll
        for (int b = 0; b < 2; ++b)
#pragma unroll
            for (int m = 0; m < 4; ++m)
#pragma unroll
                for (int n = 0; n < 2; ++n) acc[a][b][m][n] = (f32x4){0.f, 0.f, 0.f, 0.f};
    bf16x8 At[4][2], B0[2][2], B1[2][2];
    const char* cA = (const char*)g.A + (size_t)cur.pm * tstep; const char* cB = (const char*)g.Bt + (size_t)cur.pn * tstep;
    PG8_STAGE(PG8_SB(0, 0), cB, voffB); PG8_STAGE(PG8_SA(0, 0), cA, voffA); PG8_STAGE(PG8_SB(0, 1), cB + hstep, voffB); PG8_STAGE(PG8_SA(0, 1), cA + hstep, voffA);
    if (wr == 1) PG8_BAR;
    PG8_WAIT_V(4); PG8_BAR;
    PG8_STAGE(PG8_SB(1, 0), cB + kstep, voffB); PG8_STAGE(PG8_SA(1, 0), cA + kstep, voffA); PG8_STAGE(PG8_SB(1, 1), cB + hstep + kstep, voffB);
    PG8_WAIT_V(6); PG8_BAR;
    for (;;) {
        const bool has_next = S.next(ui + 1, nxt);
        const char* nA = has_next ? (const char*)g.A + (size_t)nxt.pm * tstep : cA; const char* nB = has_next ? (const char*)g.Bt + (size_t)nxt.pn * tstep : cB;
        for (int t = 0; t < nt; t += 2) {
            const bool last = (t == nt - 2);
            const char* a1 = cA + (size_t)(t + 1) * kstep;
            const char* a2 = last ? nA : cA + (size_t)(t + 2) * kstep; const char* b2 = last ? nB : cB + (size_t)(t + 2) * kstep;
            const char* a3 = a2 + kstep; const char* b3 = b2 + kstep;
            PG8_LDB(B0, 0, 0); PG8_SCHED; PG8_LDA(At, 0, 0); PG8_STAGE(PG8_SA(1, 1), a1 + hstep, voffA);
            PG8_WAIT_L(8); PG8_BAR; PG8_WAIT_L(0); PG8_MMA(0, 0, At, B0); PG8_BAR; PG8_SCHED;
            PG8_LDB(B1, 0, 1); PG8_STAGE(PG8_SB(0, 0), b2, voffB);
            PG8_BAR; PG8_WAIT_L(0); PG8_MMA(0, 1, At, B1); PG8_BAR;
            PG8_LDA(At, 0, 1); PG8_STAGE(PG8_SA(0, 0), a2, voffA);
            PG8_BAR; PG8_WAIT_L(0); PG8_MMA(1, 0, At, B0); PG8_BAR; PG8_SCHED;
            PG8_STAGE(PG8_SB(0, 1), b2 + hstep, voffB);
            PG8_WAIT_V(6); PG8_BAR; PG8_MMA(1, 1, At, B1); PG8_BAR;
            PG8_LDB(B0, 1, 0); PG8_SCHED; PG8_LDA(At, 1, 0); PG8_STAGE(PG8_SA(0, 1), a2 + hstep, voffA);
            PG8_WAIT_L(8); PG8_BAR; PG8_WAIT_L(0); PG8_MMA(0, 0, At, B0); PG8_BAR; PG8_SCHED;
            PG8_LDB(B1, 1, 1); PG8_STAGE(PG8_SB(1, 0), b3, voffB);
            PG8_BAR; PG8_WAIT_L(0); PG8_MMA(0, 1, At, B1); PG8_BAR;
            PG8_LDA(At, 1, 1); PG8_STAGE(PG8_SA(1, 0), a3, voffA);
            PG8_BAR; PG8_WAIT_L(0); PG8_MMA(1, 0, At, B0); PG8_BAR; PG8_SCHED;
            PG8_STAGE(PG8_SB(1, 1), b3 + hstep, voffB);
            PG8_WAIT_V(6); PG8_BAR; PG8_MMA(1, 1, At, B1); PG8_BAR;
        }
        E(acc, cur, wr, wc, fr, fq);
        if (!has_next) break;
#pragma unroll
        for (int a = 0; a < 2; ++a)
#pragma unroll
            for (int b = 0; b < 2; ++b)
#pragma unroll
                for (int m = 0; m < 4; ++m)
#pragma unroll
                    for (int n = 0; n < 2; ++n) acc[a][b][m][n] = (f32x4){0.f, 0.f, 0.f, 0.f};
        cur = nxt; cA = nA; cB = nB; ++ui;
    }
    PG8_WAIT_V(0);
    if (wr == 0) PG8_BAR;
    PG8_BAR;
#undef PG8_SA
#undef PG8_SB
#undef PG8_STAGE
#undef PG8_LDA
#undef PG8_LDB
#undef PG8_MMA
#undef PG8_WAIT_V
#undef PG8_WAIT_L
#undef PG8_BAR
#undef PG8_SCHED
}
}

struct EpiProj {
    static constexpr bool PERM = true;
    bf16_t* O;
    template <int MODE> __device__ __forceinline__ void run(const f32x4 (&acc)[2][2][4][2], const pg8::Unit& u, int wr, int wc, int fr, int fq) const {
        const int row0 = u.pm * 256 + wr * 64 + fr, col0 = u.pn * 256 + wc * 32 + 8 * fq;
#pragma unroll
        for (int ai = 0; ai < 2; ++ai)
#pragma unroll
            for (int m = 0; m < 4; ++m) { bf16_t* rowp = O + (size_t)(row0 + ai * 128 + m * 16) * LDP + col0;
#pragma unroll
                for (int bj = 0; bj < 2; ++bj) { float f[8];
#pragma unroll
                    for (int q = 0; q < 8; ++q) { const float x = acc[ai][bj][m][q >> 2][q & 3];
                        f[q] = MODE == 0 ? gelu_tanh_f(x) : MODE == 1 ? silu_f(x) : MODE == 2 ? x : sigmoid_f(x); }
                    *(u32x4*)(rowp + bj * 128) = pack8(f); } }
    }
    __device__ __forceinline__ void operator()(const f32x4 (&acc)[2][2][4][2], const pg8::Unit& u, int wr, int wc, int fr, int fq) const {
        const int pn = u.pn;
        if (pn < 8) run<0>(acc, u, wr, wc, fr, fq);
        else if (pn < 12) run<1>(acc, u, wr, wc, fr, fq);
        else if (pn < 37) run<2>(acc, u, wr, wc, fr, fq);
        else if (pn < 45) run<1>(acc, u, wr, wc, fr, fq);
        else run<3>(acc, u, wr, wc, fr, fq);
    }
};
template <bool ADD> struct EpiMerge {
    static constexpr bool PERM = true;
    bf16_t* O; const bf16_t* G;
    __device__ __forceinline__ void operator()(const f32x4 (&acc)[2][2][4][2], const pg8::Unit& u, int wr, int wc, int fr, int fq) const {
        const int row0 = u.pm * 256 + wr * 64 + fr, col0 = u.pn * 256 + wc * 32 + 8 * fq;
#pragma unroll
        for (int ai = 0; ai < 2; ++ai)
#pragma unroll
            for (int m = 0; m < 4; ++m) { const size_t r = (size_t)(row0 + ai * 128 + m * 16);
#pragma unroll
                for (int bj = 0; bj < 2; ++bj) { const int c = col0 + bj * 128; float gt[8], f[8];
                    unpack8(*(const u32x4*)(G + r * LDP + c), gt);
                    if (ADD) unpack8(*(const u32x4*)(O + r * D + c), f);
#pragma unroll
                    for (int q = 0; q < 8; ++q) { const float x = acc[ai][bj][m][q >> 2][q & 3] * gt[q]; f[q] = ADD ? f[q] + x : x; }
                    *(u32x4*)(O + r * D + c) = pack8(f); } }
    }
};
struct EpiOut {
    static constexpr bool PERM = true;
    bf16_t* O; const float* xp; const float* xs; const float* mod;
    __device__ __forceinline__ void operator()(const f32x4 (&acc)[2][2][4][2], const pg8::Unit& u, int wr, int wc, int fr, int fq) const {
        const int row0 = u.pm * 256 + wr * 64 + fr, col0 = u.pn * 256 + wc * 32 + 8 * fq;
#pragma unroll
        for (int ai = 0; ai < 2; ++ai)
#pragma unroll
            for (int m = 0; m < 4; ++m) { const int r = row0 + ai * 128 + m * 16;
                if (r < NTOK) { const float* x = r < NTOK_P ? xp + (size_t)r * D : xs + (size_t)(r - NTOK_P) * D; const int b = r < NTOK_P ? (r >> 11) : 4 + (r - NTOK_P);
                    const float* gate = mod + (size_t)b * 6144 + 4096;
#pragma unroll
                    for (int bj = 0; bj < 2; ++bj) { const int c = col0 + bj * 128; float f[8];
                        const f32x4 x0 = *(const f32x4*)(x + c), x1 = *(const f32x4*)(x + c + 4), g0 = *(const f32x4*)(gate + c), g1 = *(const f32x4*)(gate + c + 4);
                        const f32x4 o0 = x0 + g0 * acc[ai][bj][m][0], o1 = x1 + g1 * acc[ai][bj][m][1];
                        f[0] = o0[0]; f[1] = o0[1]; f[2] = o0[2]; f[3] = o0[3]; f[4] = o1[0]; f[5] = o1[1]; f[6] = o1[2]; f[7] = o1[3];
                        *(u32x4*)(O + (size_t)r * D + c) = pack8(f); } } }
    }
};

typedef float f32x16 __attribute__((ext_vector_type(16)));
template <class Epi> __device__ __forceinline__ void small_gemm(const bf16_t* __restrict__ A, const bf16_t* __restrict__ Bt, int K, LAS float* red, const Epi& epi) {
    const int tid = tid_opaque(), wid = tid >> 6, lane = tid & 63, l31 = lane & 31, lh = lane >> 5;
    for (int tile = blockIdx.x; tile < 256; tile += gridDim.x) {
        const int r0 = (tile & 3) * 32, n0 = (tile >> 2) * 32, kw = wid * (K >> 3), ns = K >> 7;
        const bf16_t* ap = A + (size_t)(r0 + l31) * K + kw + lh * 8; const bf16_t* bp = Bt + (size_t)(n0 + l31) * K + kw + lh * 8;
        f32x16 acc;
#pragma unroll
        for (int v = 0; v < 16; ++v) acc[v] = 0.f;
#pragma unroll 8
        for (int st = 0; st < ns; ++st) { const bf16x8 af = *(const bf16x8*)(ap + st * 16), bf = *(const bf16x8*)(bp + st * 16);
            acc = __builtin_amdgcn_mfma_f32_32x32x16_bf16(bf, af, acc, 0, 0, 0); }
#pragma unroll
        for (int v = 0; v < 16; ++v) red[(wid * 16 + v) * 64 + lane] = acc[v];
        __syncthreads();
        if (tid < 256) { const int g = tid >> 6; f32x4 sum = (f32x4){0.f, 0.f, 0.f, 0.f};
#pragma unroll
            for (int w = 0; w < 8; ++w)
#pragma unroll
                for (int j = 0; j < 4; ++j) sum[j] += red[(w * 16 + g * 4 + j) * 64 + lane];
            epi(sum, r0 + l31, n0 + 8 * g + 4 * lh); }
        __syncthreads();
    }
}

__device__ void mod_tile(PP p, int tile, LAS float* red) {
    const int tid = tid_opaque(), wid = tid >> 6, lane = tid & 63, fr = lane & 15, fq = lane >> 4, n0 = tile * 32;
    const float* wc = p->in[I_WC];
    f32x4 acc[9][2];
#pragma unroll
    for (int a = 0; a < 9; ++a) { acc[a][0] = (f32x4){0.f, 0.f, 0.f, 0.f}; acc[a][1] = (f32x4){0.f, 0.f, 0.f, 0.f}; }
    float bw[2][8], bn[2][8];
#pragma unroll
    for (int nt = 0; nt < 2; ++nt)
#pragma unroll
        for (int j = 0; j < 8; ++j) bw[nt][j] = wc[(size_t)(wid * 256 + fq * 8 + j) * 6144 + n0 + nt * 16 + fr];
#pragma unroll 1
    for (int ks = 0; ks < 8; ++ks) { const int k0 = wid * 256 + ks * 32 + fq * 8;
        if (ks + 1 < 8) {
#pragma unroll
            for (int nt = 0; nt < 2; ++nt)
#pragma unroll
                for (int j = 0; j < 8; ++j) bn[nt][j] = wc[(size_t)(k0 + 32 + j) * 6144 + n0 + nt * 16 + fr]; }
        f32x4 av[9][2];
#pragma unroll
        for (int mt = 0; mt < 9; ++mt) { const int r = mt * 16 + fr;
            if (r < NMODROW) { const float* cp = (r < 4 ? p->in[I_CP] + (size_t)r * D : p->in[I_CS] + (size_t)(r - 4) * D) + k0; av[mt][0] = *(const f32x4*)cp; av[mt][1] = *(const f32x4*)(cp + 4); }
            else { av[mt][0] = (f32x4){0.f, 0.f, 0.f, 0.f}; av[mt][1] = av[mt][0]; } }
        bf16x8 bfr[2];
#pragma unroll
        for (int nt = 0; nt < 2; ++nt) { const u32x4 pk = pack8(bw[nt]); bfr[nt] = __builtin_bit_cast(bf16x8, pk); }
#pragma unroll
        for (int mt = 0; mt < 9; ++mt) { u32x4 pk; pk[0] = cvt_pk_bf16(av[mt][0][0], av[mt][0][1]); pk[1] = cvt_pk_bf16(av[mt][0][2], av[mt][0][3]); pk[2] = cvt_pk_bf16(av[mt][1][0], av[mt][1][1]); pk[3] = cvt_pk_bf16(av[mt][1][2], av[mt][1][3]);
            const bf16x8 afr = __builtin_bit_cast(bf16x8, pk);
            acc[mt][0] = __builtin_amdgcn_mfma_f32_16x16x32_bf16(afr, bfr[0], acc[mt][0], 0, 0, 0);
            acc[mt][1] = __builtin_amdgcn_mfma_f32_16x16x32_bf16(afr, bfr[1], acc[mt][1], 0, 0, 0); }
#pragma unroll
        for (int nt = 0; nt < 2; ++nt)
#pragma unroll
            for (int j = 0; j < 8; ++j) bw[nt][j] = bn[nt][j];
    }
    if (wid >= 4) {
#pragma unroll
        for (int mt = 0; mt < 9; ++mt)
#pragma unroll
            for (int nt = 0; nt < 2; ++nt)
#pragma unroll
                for (int j = 0; j < 4; ++j) red[(wid - 4) * 4608 + (mt * 16 + fq * 4 + j) * 32 + nt * 16 + fr] = acc[mt][nt][j]; }
    __syncthreads();
    if (wid < 4) {
#pragma unroll
        for (int mt = 0; mt < 9; ++mt)
#pragma unroll
            for (int nt = 0; nt < 2; ++nt)
#pragma unroll
                for (int j = 0; j < 4; ++j) red[wid * 4608 + (mt * 16 + fq * 4 + j) * 32 + nt * 16 + fr] += acc[mt][nt][j]; }
    __syncthreads();
    float* mod = (float*)(p->ws + WS_MOD); const float* bc = p->in[I_BC];
    for (int i = tid; i < NMODROW * 32; i += 512) { const int r = i >> 5, c = i & 31; mod[(size_t)r * 6144 + n0 + c] = ((red[i] + red[4608 + i]) + (red[9216 + i] + red[13824 + i])) + bc[n0 + c]; }
    __syncthreads();
}
constexpr int T0_MOD = 192, T0_WIN = 8 * 243, T0_PA = 4 * 32, T0_PB = 8 * 32, T0_WOUT = 8 * 32, NCONV_ALL = T0_WIN + T0_PA + T0_PB + T0_WOUT;
__device__ __forceinline__ void conv_desc(PP p, int u, const float*& sp, int& Nsrc, bf16_t*& dp, int& K) {
    if (u < T0_WIN) { const int tn = u >> 3, tk = u & 7; Nsrc = IN_W; K = D; sp = p->in[I_WIN] + (size_t)tk * 256 * IN_W + tn * 64; dp = (bf16_t*)(p->ws + WS_WTIN) + (size_t)(tn * 64 + (tn >= 147 ? 64 : 0)) * D + tk * 256; return; }
    u -= T0_WIN; Nsrc = D;
    if (u < T0_PA) { const int tk = u & 3, tn = u >> 2; K = A_W; sp = p->in[I_PA] + (size_t)tk * 256 * D + tn * 64; dp = (bf16_t*)(p->ws + WS_WTPA) + (size_t)tn * 64 * A_W + tk * 256; return; }
    u -= T0_PA; K = D; const int tk = u & 7, tn = (u >> 3) & 31;
    if (u < T0_PB) { sp = p->in[I_PB] + (size_t)tk * 256 * D + tn * 64; dp = (bf16_t*)(p->ws + WS_WTPB) + (size_t)tn * 64 * D + tk * 256; return; }
    { sp = p->in[I_WOUT] + (size_t)tk * 256 * D + tn * 64; dp = (bf16_t*)(p->ws + WS_WTOUT) + (size_t)tn * 64 * D + tk * 256; }
}
__device__ void phase0(PP p, LAS unsigned char* lds) {
    const int tid = tid_opaque();
    REP(13) for (int t = blockIdx.x; t < T0_MOD; t += gridDim.x) mod_tile(p, t, (LAS float*)lds);
    const int rb = gridDim.x - 1 - blockIdx.x;
    if (rb == 0) { u32x4* z = (u32x4*)(p->ws + WS_WTIN + (size_t)9408 * D * 2); for (int i = tid; i < 64 * D * 2 / 16; i += 512) z[i] = (u32x4){0u, 0u, 0u, 0u}; }
    for (int it = blockIdx.x; it < 256; it += gridDim.x) { const int w = it >> 7, n0 = (it & 127) * 16; const float* src = p->in[w ? I_A2 : I_W2]; bf16_t* dst = (bf16_t*)(p->ws + (w ? WS_A2T : WS_W2T));
#pragma unroll
        for (int j = 0; j < 3; ++j) { const int i = tid + j * 512, nl = i / 96, k = i % 96; dst[(size_t)(n0 + nl) * 96 + k] = f2bf(src[(size_t)k * B_W + n0 + nl]); } }
    LAS float* t = (LAS float*)lds; volatile LAS int* slot = (volatile LAS int*)(lds + 256 * 65 * 4);
    unsigned* q = (unsigned*)(p->ws + WS_BAR) + 64;
    __syncthreads();
    if (tid == 0) slot[0] = (int)atomicAdd(q, 2u);
    __syncthreads();
    const int NCONV = (gridDim.x == 256) ? T0_WIN : NCONV_ALL;
    int cur = slot[0], nxt = cur + 1;
    f32x4 rg[8], rn[8];
    auto load = [&](int u, f32x4 (&r)[8]) { const float* sp; int Nsrc, K; bf16_t* dp; conv_desc(p, u, sp, Nsrc, dp, K);
#pragma unroll
        for (int i = 0; i < 8; ++i) { const int idx = tid + i * 512; r[i] = *(const f32x4*)(sp + (size_t)(idx >> 4) * Nsrc + (idx & 15) * 4); } };
    if (cur < NCONV) load(cur, rg);
    while (cur < NCONV) {
        int claimed = 0;
        if (tid == 0) claimed = (int)atomicAdd(q, 1u);
        if (nxt < NCONV) load(nxt, rn);
        __syncthreads();
        if (tid == 0) slot[0] = claimed;
#pragma unroll
        for (int i = 0; i < 8; ++i) { const int idx = tid + i * 512, row = idx >> 4, cb = (idx & 15) * 4, hx = (row >> 5) & 7;
            t[row * 65 + (cb ^ hx)] = rg[i][0]; t[row * 65 + ((cb + 1) ^ hx)] = rg[i][1]; t[row * 65 + ((cb + 2) ^ hx)] = rg[i][2]; t[row * 65 + ((cb + 3) ^ hx)] = rg[i][3]; }
        __syncthreads();
        const int n2 = slot[0];
        { const float* sp; int Nsrc, K; bf16_t* dp; conv_desc(p, cur, sp, Nsrc, dp, K);
#pragma unroll
            for (int i = 0; i < 4; ++i) { const int ch = tid + i * 512, nl = ch >> 5, kc = ch & 31; float f[8];
#pragma unroll
                for (int j = 0; j < 8; ++j) f[j] = t[(kc * 8 + j) * 65 + (nl ^ ((kc >> 2) & 7))];
                *(u32x4*)(dp + (size_t)nl * K + kc * 8) = pack8(f); } }
        cur = nxt; nxt = n2;
#pragma unroll
        for (int i = 0; i < 8; ++i) rg[i] = rn[i];
    }
    __syncthreads();
}

__device__ void phase1(PP p) {
    const int tid = tid_opaque(), lane = tid & 63, gw = blockIdx.x * 8 + (tid >> 6), nw = gridDim.x * 8;
    bf16_t* H = (bf16_t*)(p->ws + WS_H); const float* mod = (const float*)(p->ws + WS_MOD); const float* ng = p->in[I_NORMG];
    f32x4 g[8];
#pragma unroll
    for (int i = 0; i < 8; ++i) g[i] = *(const f32x4*)(ng + (lane + 64 * i) * 4);
    auto xrow = [&](int r) { return r < NTOK_P ? p->in[I_XP] + (size_t)r * D : p->in[I_XS] + (size_t)(r - NTOK_P) * D; };
    f32x4 v[8], vn[8];
    if (gw < NTOK) {
#pragma unroll
        for (int i = 0; i < 8; ++i) v[i] = *(const f32x4*)(xrow(gw) + (lane + 64 * i) * 4); }
    for (int r = gw; r < MP; r += nw) {
        bf16_t* hrow = H + (size_t)r * D;
        if (r >= NTOK) { for (int i = 0; i < 4; ++i) *(u32x4*)(hrow + (lane + 64 * i) * 8) = (u32x4){0u, 0u, 0u, 0u}; continue; }
        const int rn = r + nw;
        if (rn < NTOK) {
#pragma unroll
            for (int i = 0; i < 8; ++i) vn[i] = *(const f32x4*)(xrow(rn) + (lane + 64 * i) * 4); }
        const int b = r < NTOK_P ? (r >> 11) : 4 + (r - NTOK_P);
        const float* mrow = mod + (size_t)b * 6144;
        float ss = 0.f;
#pragma unroll
        for (int i = 0; i < 8; ++i) ss += v[i][0] * v[i][0] + v[i][1] * v[i][1] + v[i][2] * v[i][2] + v[i][3] * v[i][3];
        ss = wave_sum(ss); const float rstd = rsqrtf(ss * (1.f / D) + 1e-6f);
#pragma unroll
        for (int i = 0; i < 8; ++i) { const int c = (lane + 64 * i) * 4; const f32x4 sh = *(const f32x4*)(mrow + c), sc = *(const f32x4*)(mrow + 2048 + c);
            const f32x4 h = v[i] * rstd * g[i] * (sc + 1.f) + sh; u32x2 o; o[0] = cvt_pk_bf16(h[0], h[1]); o[1] = cvt_pk_bf16(h[2], h[3]); *(u32x2*)(hrow + c) = o; }
#pragma unroll
        for (int i = 0; i < 8; ++i) v[i] = vn[i];
    }
}

__device__ void mixa_tile(PP p, int tile, LAS unsigned char* lds) {
    const int tid = tid_opaque(), wid = tid >> 6, lane = tid & 63, fr = lane & 15, fq = lane >> 4;
    const int b = tile >> 7, nck = (tile >> 3) & 15, g = tile & 7, row0 = b * SEQ + nck * 128;
    const bf16_t* PROJ = (const bf16_t*)(p->ws + WS_PROJ); bf16_t* YA = (bf16_t*)(p->ws + WS_YA);
    LAS float* mu = (LAS float*)lds; LAS float* rs = mu + 128;
    LAS bf16_t* wA = (LAS bf16_t*)(lds + 1024); LAS bf16_t* vT = wA + 128 * 136;
#pragma unroll
    for (int hb = 0; hb < 2; ++hb) { u32x4 ra[8], rc[8];
#pragma unroll
        for (int k = 0; k < 8; ++k) { const bf16_t* vr = PROJ + (size_t)(row0 + wid * 16 + hb * 8 + k) * LDP + C_VA; ra[k] = *(const u32x4*)(vr + lane * 8); rc[k] = *(const u32x4*)(vr + 512 + lane * 8); }
#pragma unroll
        for (int k = 0; k < 8; ++k) { float a[8], c[8]; unpack8(ra[k], a); unpack8(rc[k], c); float s = 0.f, s2 = 0.f;
#pragma unroll
            for (int q = 0; q < 8; ++q) { s += a[q] + c[q]; s2 += a[q] * a[q] + c[q] * c[q]; }
            s = wave_sum(s); s2 = wave_sum(s2); const float m = s * (1.f / A_W), var = fmaxf(s2 * (1.f / A_W) - m * m, 0.f);
            if (lane == 0) { const int tl = wid * 16 + hb * 8 + k; mu[tl] = m; rs[tl] = rsqrtf(var + 1e-6f); } } }
    const float* wsrc = p->in[I_WS] + (size_t)g * 128 * 128;
#pragma unroll
    for (int i = 0; i < 8; ++i) { const int idx = tid + i * 512, t = idx >> 5, s4 = (idx & 31) * 4; const f32x4 w = *(const f32x4*)(wsrc + t * 128 + s4);
        u32x2 o; o[0] = cvt_pk_bf16(s4 <= t ? w[0] : 0.f, s4 + 1 <= t ? w[1] : 0.f); o[1] = cvt_pk_bf16(s4 + 2 <= t ? w[2] : 0.f, s4 + 3 <= t ? w[3] : 0.f);
        *(LAS u32x2*)(wA + t * 136 + s4) = o; }
    __syncthreads();
    const float* lng = p->in[I_LNG] + g * 128; const float* lnb = p->in[I_LNB] + g * 128;
    u32x2 uar[8], zar[8];
    { const int rowe = row0 + wid * 16 + fr;
#pragma unroll
      for (int ct = 0; ct < 8; ++ct) { const int c = g * 128 + ct * 16 + fq * 4; uar[ct] = *(const u32x2*)(PROJ + (size_t)rowe * LDP + C_UA + c); zar[ct] = *(const u32x2*)(PROJ + (size_t)rowe * LDP + C_ZA + c); } }
#pragma unroll
    for (int i = 0; i < 4; ++i) { const int idx = tid + i * 512, s = idx >> 4, c8 = (idx & 15) * 8; float x[8];
        unpack8(*(const u32x4*)(PROJ + (size_t)(row0 + s) * LDP + C_VA + g * 128 + c8), x); const float m = mu[s], r = rs[s];
        const f32x4 g0 = *(const f32x4*)(lng + c8), g1 = *(const f32x4*)(lng + c8 + 4), b0 = *(const f32x4*)(lnb + c8), b1 = *(const f32x4*)(lnb + c8 + 4);
        const int ssw = s ^ (((c8 >> 3) & 7) << 3);
#pragma unroll
        for (int q = 0; q < 8; ++q) vT[(c8 + q) * 136 + ssw] = f2bf((x[q] - m) * r * (q < 4 ? g0[q & 3] : g1[q & 3]) + (q < 4 ? b0[q & 3] : b1[q & 3])); }
    __syncthreads();
    const int t0 = wid * 16, nks = (t0 + 15) / 32 + 1;
    bf16x8 af[4];
#pragma unroll
    for (int ks = 0; ks < 4; ++ks) af[ks] = *(const LAS bf16x8*)(wA + (t0 + fr) * 136 + (ks < nks ? ks : 0) * 32 + fq * 8);
    const int row = row0 + t0 + fr; const float bias = p->in[I_BS][g * 128 + t0 + fr];
#pragma unroll
    for (int ct = 0; ct < 8; ++ct) { f32x4 acc = (f32x4){0.f, 0.f, 0.f, 0.f};
#pragma unroll
        for (int ks = 0; ks < 4; ++ks) if (ks < nks) { const int cch = ct * 16 + fr; const bf16x8 bfr = *(const LAS bf16x8*)(vT + cch * 136 + ((ks * 32 + fq * 8) ^ (((cch >> 3) & 7) << 3)));
            acc = __builtin_amdgcn_mfma_f32_16x16x32_bf16(bfr, af[ks], acc, 0, 0, 0); }
        const int c = g * 128 + ct * 16 + fq * 4;
        const u32x2 ua = uar[ct], za = zar[ct];
        u32x2 o; o[0] = cvt_pk_bf16(bflo(ua[0]) * (acc[0] + bias) * bflo(za[0]), bfhi(ua[0]) * (acc[1] + bias) * bfhi(za[0]));
        o[1] = cvt_pk_bf16(bflo(ua[1]) * (acc[2] + bias) * bflo(za[1]), bfhi(ua[1]) * (acc[3] + bias) * bfhi(za[1]));
        *(u32x2*)(YA + (size_t)row * A_W + c) = o; }
    __syncthreads();
}
__device__ void mixa_sample_row(PP p, int bs) {
    const int lane = tid_opaque() & 63, row = NTOK_P + bs;
    const bf16_t* pr = (const bf16_t*)(p->ws + WS_PROJ) + (size_t)row * LDP; bf16_t* YA = (bf16_t*)(p->ws + WS_YA) + (size_t)row * A_W; float* cv = p->out + O_CV + (size_t)bs * A_W;
    float x[2][8]; unpack8(*(const u32x4*)(pr + C_VA + lane * 8), x[0]); unpack8(*(const u32x4*)(pr + C_VA + 512 + lane * 8), x[1]);
    float s = 0.f, s2 = 0.f;
#pragma unroll
    for (int q = 0; q < 8; ++q) { s += x[0][q] + x[1][q]; s2 += x[0][q] * x[0][q] + x[1][q] * x[1][q]; }
    s = wave_sum(s); s2 = wave_sum(s2); const float m = s * (1.f / A_W), r = rsqrtf(fmaxf(s2 * (1.f / A_W) - m * m, 0.f) + 1e-6f);
#pragma unroll
    for (int hlf = 0; hlf < 2; ++hlf) { const int c0 = hlf * 512 + lane * 8, g = c0 >> 7; const float w00 = p->in[I_WS][(size_t)g * 128 * 128], b0 = p->in[I_BS][g * 128];
        float ua[8], za[8], f[8], vn[8]; unpack8(*(const u32x4*)(pr + C_UA + c0), ua); unpack8(*(const u32x4*)(pr + C_ZA + c0), za);
#pragma unroll
        for (int q = 0; q < 8; ++q) { vn[q] = (x[hlf][q] - m) * r * p->in[I_LNG][c0 + q] + p->in[I_LNB][c0 + q]; f[q] = ua[q] * (w00 * vn[q] + b0) * za[q]; }
        *(f32x4*)(cv + c0) = (f32x4){vn[0], vn[1], vn[2], vn[3]}; *(f32x4*)(cv + c0 + 4) = (f32x4){vn[4], vn[5], vn[6], vn[7]};
        *(u32x4*)(YA + c0) = pack8(f); }
}

template <bool SMP> __device__ __forceinline__ void lora_stage(PP p, int T0, int tid, LAS bf16_t* Aw, LAS bf16_t* Aa) {
    const bf16_t* PROJ = (const bf16_t*)(p->ws + WS_PROJ); const float* mu = p->in[I_MU];
#pragma unroll 1
    for (int hb = 0; hb < 2; ++hb) {
        u32x4 cur[4], prv[4]; f32x4 pf0[4], pf1[4];
#pragma unroll
        for (int k = 0; k < 4; ++k) { const int idx = tid + (hb * 4 + k) * 512, which = idx >= 144 * 12, i2 = which ? idx - 144 * 12 : idx, tl = i2 / 12, ch = i2 % 12, row = T0 + tl, off = (which ? PR_AD : PR_WD) + ch * 8;
            const bool act = idx < 144 * 12 * 2 && tl < 130 && (SMP ? row >= NTOK_P : row < NTOK_P);
            const int srow = act ? row : T0;
            const bf16_t* pr = PROJ + (size_t)srow * LDP + C_PR + off; cur[k] = *(const u32x4*)pr;
            if (SMP) { const float* sh = p->in[I_SSH] + (size_t)(act ? row - NTOK_P : 0) * SHIFT_W + off; pf0[k] = *(const f32x4*)sh; pf1[k] = *(const f32x4*)(sh + 4); prv[k] = cur[k]; }
            else { const bool first = !act || (srow & (SEQ - 1)) == 0; prv[k] = *(const u32x4*)(first ? pr : pr - LDP); pf0[k] = (f32x4){0.f, 0.f, 0.f, 0.f}; pf1[k] = pf0[k]; } }
#pragma unroll
        for (int k = 0; k < 4; ++k) { const int idx = tid + (hb * 4 + k) * 512, which = idx >= 144 * 12, i2 = which ? idx - 144 * 12 : idx, tl = i2 / 12, ch = i2 % 12, row = T0 + tl, off = (which ? PR_AD : PR_WD) + ch * 8;
            const bool inr = idx < 144 * 12 * 2, act = inr && tl < 130 && (SMP ? row >= NTOK_P : row < NTOK_P);
            const f32x4 m0 = *(const f32x4*)(mu + off), m1 = *(const f32x4*)(mu + off + 4);
            float c[8], pv[8], f[8]; unpack8(cur[k], c);
            if (SMP) { pv[0] = pf0[k][0]; pv[1] = pf0[k][1]; pv[2] = pf0[k][2]; pv[3] = pf0[k][3]; pv[4] = pf1[k][0]; pv[5] = pf1[k][1]; pv[6] = pf1[k][2]; pv[7] = pf1[k][3]; }
            else { unpack8(prv[k], pv); const float keep = (row & (SEQ - 1)) == 0 ? 0.f : 1.f;
#pragma unroll
                for (int q = 0; q < 8; ++q) pv[q] *= keep; }
#pragma unroll
            for (int q = 0; q < 8; ++q) { const float x = c[q] + (q < 4 ? m0[q & 3] : m1[q & 3]) * (pv[q] - c[q]); f[q] = which ? x : tanh_fast(x); }
            const u32x4 o = act ? pack8(f) : (u32x4){0u, 0u, 0u, 0u};
            if (SMP ? act : (inr && (tl >= 130 || row < NTOK_P))) *(LAS u32x4*)((which ? Aa : Aw) + tl * 104 + ch * 8) = o; }
    }
}
__device__ void lora_tile(PP p, int tile, LAS unsigned char* lds) {
    const int tid = tid_opaque(), wid = tid >> 6, lane = tid & 63, fr = lane & 15, fq = lane >> 4, cs = tile & 3, T0 = (tile >> 2) * 130;
    const bf16_t* PROJ = (const bf16_t*)(p->ws + WS_PROJ); const float* mu = p->in[I_MU];
    LAS bf16_t* Aw = (LAS bf16_t*)lds; LAS bf16_t* Aa = Aw + 144 * 104;
    bf16x8 bfr[2][4][3]; f32x4 bias[2][4];
#pragma unroll
    for (int lo = 0; lo < 2; ++lo) { const bf16_t* Bt = (const bf16_t*)(p->ws + (lo ? WS_A2T : WS_W2T)); const float* b0 = p->in[lo ? I_A0 : I_W0];
#pragma unroll
        for (int nt = 0; nt < 4; ++nt) { const int n0 = cs * 512 + wid * 64 + nt * 16; bias[lo][nt] = *(const f32x4*)(b0 + n0 + fq * 4);
#pragma unroll
            for (int ks = 0; ks < 3; ++ks) bfr[lo][nt][ks] = *(const bf16x8*)(Bt + (size_t)(n0 + fr) * 96 + ks * 32 + fq * 8); } }
    lora_stage<false>(p, T0, tid, Aw, Aa);
    if (T0 + 130 > NTOK_P) lora_stage<true>(p, T0, tid, Aw, Aa);
    __syncthreads();
#pragma unroll 1
    for (int mt = 0; mt < 9; ++mt) { const int tl = mt * 16 + fr, row = T0 + tl; const bool ok = tl < 130;
#pragma unroll
        for (int lo = 0; lo < 2; ++lo) { const LAS bf16_t* A = lo ? Aa : Aw; bf16x8 af[3];
#pragma unroll
            for (int ks = 0; ks < 3; ++ks) af[ks] = *(const LAS bf16x8*)(A + tl * 104 + ks * 32 + fq * 8);
            bf16_t* op = lo ? (bf16_t*)(p->ws + WS_AAA) + (size_t)row * D : (row >= NTOK_P ? (bf16_t*)(p->ws + WS_ES) + (size_t)(row - NTOK_P) * D : (bf16_t*)(p->ws + WS_E) + (size_t)row * D);
            const float mul = lo ? 1.f : 0.6065306597126334f;
#pragma unroll
            for (int nt = 0; nt < 4; ++nt) { f32x4 acc = (f32x4){0.f, 0.f, 0.f, 0.f};
#pragma unroll
                for (int ks = 0; ks < 3; ++ks) acc = __builtin_amdgcn_mfma_f32_16x16x32_bf16(bfr[lo][nt][ks], af[ks], acc, 0, 0, 0);
                u32x2 o; o[0] = cvt_pk_bf16(sigmoid_f(acc[0] + bias[lo][nt][0]) * mul, sigmoid_f(acc[1] + bias[lo][nt][1]) * mul); o[1] = cvt_pk_bf16(sigmoid_f(acc[2] + bias[lo][nt][2]) * mul, sigmoid_f(acc[3] + bias[lo][nt][3]) * mul);
                if (ok) *(u32x2*)(op + cs * 512 + wid * 64 + nt * 16 + fq * 4) = o; } } }
    __syncthreads();
}
constexpr int T3_MIXA = 512, T3_MIXS = 16, T3_LORA = 256, T3_TOTAL = T3_MIXA + T3_MIXS + T3_LORA;
__device__ void phase3(PP p, LAS unsigned char* lds) {
    REP(11) for (int t = blockIdx.x; t < T3_MIXA + T3_MIXS; t += gridDim.x) {
        if (t < T3_MIXA) mixa_tile(p, t, lds);
        else mixa_sample_row(p, (t - T3_MIXA) * 8 + (tid_opaque() >> 6));
    }
    REP(12) for (int t = blockIdx.x; t < T3_LORA; t += gridDim.x) lora_tile(p, (t + 16) % T3_LORA, lds);
}

struct HeadPar { float mu_r, mu_k, mu_v, kk_s, ka, rk; };
__device__ __forceinline__ float head_vectors(const HeadPar& hp, float r_c, float k_c, float v_c, float r_p, float k_p, float v_p, float a, float e, LAS float* dst, int j, float& v_out) {
    const float r = r_c + hp.mu_r * (r_p - r_c), k = k_c + hp.mu_k * (k_p - k_c), v = v_c + hp.mu_v * (v_p - v_c);
    const float w = __expf(-e);
    float kk = k * hp.kk_s; const float n2 = wave_sum(kk * kk); kk = kk / fmaxf(sqrtf(n2), 1e-12f);
    const float kp = k * (1.f + (a - 1.f) * hp.ka), bb = kk * a;
    const float cc = wave_sum(r * kp * hp.rk);
    dst[j] = r; dst[64 + j] = w; dst[128 + j] = kp; dst[192 + j] = kk; dst[256 + j] = bb; dst[320 + j] = v; v_out = v;
    return cc;
}
struct SmpRegs { f32x4 S[16]; bf16_t r_c, k_c, v_c, e, a, zb; float r_p, k_p, v_p, gng, gnb; HeadPar hp; };
__device__ __forceinline__ void smp_load(PP p, int item, SmpRegs& R, int lane_) {
    int lane = lane_; asm volatile("" : "+v"(lane));
    const int bs = item >> 5, h = item & 31, hc = h * 64 + lane; const size_t row = NTOK_P + bs;
    const bf16_t* PROJ = (const bf16_t*)(p->ws + WS_PROJ);
    const bf16_t* pr = PROJ + row * LDP + C_PR + hc; const float* sh = p->in[I_SSH] + (size_t)bs * SHIFT_W + hc;
    R.r_c = pr[PR_R]; R.k_c = pr[PR_K]; R.v_c = pr[PR_V]; R.r_p = sh[PR_R]; R.k_p = sh[PR_K]; R.v_p = sh[PR_V];
    R.e = ((const bf16_t*)(p->ws + WS_ES))[(size_t)bs * D + hc]; R.a = ((const bf16_t*)(p->ws + WS_AAA))[row * D + hc]; R.zb = PROJ[row * LDP + C_ZB + hc];
    R.hp.mu_r = p->in[I_MU][PR_R + hc]; R.hp.mu_k = p->in[I_MU][PR_K + hc]; R.hp.mu_v = p->in[I_MU][PR_V + hc]; R.hp.kk_s = p->in[I_KK][hc]; R.hp.ka = p->in[I_KA][hc]; R.hp.rk = p->in[I_RK][hc];
    R.gng = p->in[I_GNG][hc]; R.gnb = p->in[I_GNB][hc];
    const float* s0 = p->in[I_SWKV] + ((size_t)(bs * 32 + h) * 64 + lane) * 64;
#pragma unroll
    for (int q = 0; q < 16; ++q) R.S[q] = *(const f32x4*)(s0 + q * 4);
}
__device__ __forceinline__ void smp_finish(PP p, int item, SmpRegs& R, LAS float* wl, int lane_) {
    int lane = lane_; asm volatile("" : "+v"(lane));
    const int bs = item >> 5, h = item & 31, hc = h * 64 + lane; const size_t row = NTOK_P + bs;
    float v; const float cc = head_vectors(R.hp, bf2f(R.r_c), bf2f(R.k_c), bf2f(R.v_c), R.r_p, R.k_p, R.v_p, bf2f(R.a), bf2f(R.e), wl, lane, v);
    __builtin_amdgcn_wave_barrier();
    float* s1 = p->out + O_WKVS + ((size_t)(bs * 32 + h) * 64 + lane) * 64;
    float sp = 0.f;
#pragma unroll
    for (int q = 0; q < 16; ++q) { const f32x4 kk = *(const LAS f32x4*)(wl + 192 + q * 4); sp += R.S[q][0] * kk[0] + R.S[q][1] * kk[1] + R.S[q][2] * kk[2] + R.S[q][3] * kk[3]; if ((q & 3) == 3) __builtin_amdgcn_sched_barrier(0); }
    const float sa = -sp; float y = 0.f;
#pragma unroll
    for (int q = 0; q < 16; ++q) { const f32x4 w = *(const LAS f32x4*)(wl + 64 + q * 4), bb = *(const LAS f32x4*)(wl + 256 + q * 4), kp = *(const LAS f32x4*)(wl + 128 + q * 4), r = *(const LAS f32x4*)(wl + q * 4);
        const f32x4 sn = R.S[q] * w + sa * bb + v * kp; y += sn[0] * r[0] + sn[1] * r[1] + sn[2] * r[2] + sn[3] * r[3]; *(f32x4*)(s1 + q * 4) = sn; if ((q & 1) == 1) __builtin_amdgcn_sched_barrier(0); }
    const float m = wave_sum(y) * (1.f / 64.f), d = y - m, var = wave_sum(d * d) * (1.f / 64.f);
    const float yn = d * rsqrtf(var + 64e-5f) * R.gng + R.gnb;
    ((bf16_t*)(p->ws + WS_YB))[row * D + hc] = f2bf((yn + cc * v) * bf2f(R.zb));
    __builtin_amdgcn_wave_barrier();
}
__device__ void scan_sample_item(PP p, int item, LAS float* wl) {
    const int lane = tid_opaque() & 63; SmpRegs R; smp_load(p, item, R, lane); smp_finish(p, item, R, wl, lane);
}
constexpr int BGC_PA = 32 * 32, BGC_PB = 64 * 32, BGC_WO = 64 * 32, BGC_TOTAL = BGC_PA + BGC_PB + BGC_WO, BGC_WAVES = 768;
struct BgcRegs { f32x4 r[8]; };
__device__ __forceinline__ void bgc_desc(PP p, int u, const float*& sp, bf16_t*& dp, int& K) {
    if (u < BGC_PA) { const int tk = u & 31, tn = u >> 5; K = A_W; sp = p->in[I_PA] + (size_t)tk * 32 * D + tn * 64; dp = (bf16_t*)(p->ws + WS_WTPA) + (size_t)tn * 64 * A_W + tk * 32; return; }
    u -= BGC_PA; K = D; const int tk = u & 63, tn = (u >> 6) & 31;
    if (u < BGC_PB) { sp = p->in[I_PB] + (size_t)tk * 32 * D + tn * 64; dp = (bf16_t*)(p->ws + WS_WTPB) + (size_t)tn * 64 * D + tk * 32; return; }
    sp = p->in[I_WOUT] + (size_t)tk * 32 * D + tn * 64; dp = (bf16_t*)(p->ws + WS_WTOUT) + (size_t)tn * 64 * D + tk * 32;
}
__device__ __forceinline__ void bgc_load(PP p, int u, BgcRegs& R, int lane_) {
    int lane = lane_; asm volatile("" : "+v"(lane));
    const float* sp; bf16_t* dp; int K; bgc_desc(p, u, sp, dp, K);
#pragma unroll
    for (int i = 0; i < 8; ++i) { const int idx = lane + 64 * i; R.r[i] = *(const f32x4*)(sp + (size_t)(idx >> 4) * D + (idx & 15) * 4); }
}
__device__ __forceinline__ void bgc_finish(PP p, int u, const BgcRegs& R, LAS float* t, int lane_) {
    int lane = lane_; asm volatile("" : "+v"(lane));
    const float* sp; bf16_t* dp; int K; bgc_desc(p, u, sp, dp, K);
#pragma unroll
    for (int i = 0; i < 8; ++i) { const int idx = lane + 64 * i, o = (idx >> 4) * 65 + (idx & 15) * 4; t[o] = R.r[i][0]; t[o + 1] = R.r[i][1]; t[o + 2] = R.r[i][2]; t[o + 3] = R.r[i][3]; }
    __builtin_amdgcn_wave_barrier();
#pragma unroll
    for (int i = 0; i < 4; ++i) { const int ch = lane + 64 * i, nl = ch >> 2, kc = ch & 3; float f[8];
#pragma unroll
        for (int j = 0; j < 8; ++j) f[j] = t[(kc * 8 + j) * 65 + nl];
        *(u32x4*)(dp + (size_t)nl * K + kc * 8) = pack8(f); }
    __builtin_amdgcn_wave_barrier();
}
constexpr int TS = 32, CHF = TS * 384, NCH = SEQ / TS;
__device__ __forceinline__ float red16(float x) { x += dppf<0xB1>(x); x += dppf<0x4E>(x); x += dppf<0x141>(x); x += dppf<0x140>(x); return x; }
struct LdRegs { u32x4 rc, kc, vc, rp, kp, vp, e, a; };
struct StepRegs { f32x4 r, w, k, q, b; f32x2 v;
    __device__ __forceinline__ void ld(const LAS float* L, int cq, int i0) { r = *(const LAS f32x4*)(L + cq); w = *(const LAS f32x4*)(L + 64 + cq); k = *(const LAS f32x4*)(L + 128 + cq); q = *(const LAS f32x4*)(L + 192 + cq); b = *(const LAS f32x4*)(L + 256 + cq); v = *(const LAS f32x2*)(L + 320 + i0); } };
__device__ void scan_prompt_item(PP p, int item, LAS float* lds) {
    const int tid = tid_opaque(), wid = __builtin_amdgcn_readfirstlane(tid >> 6), lane = tid & 63;
    const int b = item >> 6, h = (item >> 1) & 31, half = item & 1;
    const bf16_t* PROJ = (const bf16_t*)(p->ws + WS_PROJ);
    if (wid >= 4) {
        const int lw = wid - 4, sl = lw * 8 + (lane >> 3), ch0 = (lane & 7) * 8, hc_ = h * 64 + ch0;
        const bf16_t* E = (const bf16_t*)(p->ws + WS_E); const bf16_t* AAA = (const bf16_t*)(p->ws + WS_AAA); float* Cc = (float*)(p->ws + WS_C);
        const bool wr_c = (half == 0) && ((lane & 7) == 0);
        auto load = [&](int c, LdRegs& R) { int hc = hc_; asm volatile("" : "+v"(hc)); const int t = c * TS + sl; const size_t row = (size_t)b * SEQ + t; const bf16_t* pr = PROJ + row * LDP + C_PR + hc;
            R.rc = *(const u32x4*)(pr + PR_R); R.kc = *(const u32x4*)(pr + PR_K); R.vc = *(const u32x4*)(pr + PR_V);
            if (t > 0) { R.rp = *(const u32x4*)(pr + PR_R - LDP); R.kp = *(const u32x4*)(pr + PR_K - LDP); R.vp = *(const u32x4*)(pr + PR_V - LDP); }
            else { R.rp = (u32x4){0u, 0u, 0u, 0u}; R.kp = R.rp; R.vp = R.rp; }
            R.e = *(const u32x4*)(E + row * D + hc); R.a = *(const u32x4*)(AAA + row * D + hc); };
        auto process = [&](int c, const LdRegs& R) { int hc = hc_; asm volatile("" : "+v"(hc)); LAS float* dst = lds + (c & 1) * CHF + sl * 384 + ch0;
            float rc[8], kc[8], vc[8], rp[8], kp[8], vp[8], e[8], a[8], r[8], k[8], v[8], w[8], kk[8], kq[8], bb[8];
            float mu_r[8], mu_k[8], mu_v[8], kks[8], ka[8], rk[8];
            { const float* mb = p->in[I_MU] + hc; const f32x4 a0 = *(const f32x4*)(mb + PR_R), a1 = *(const f32x4*)(mb + PR_R + 4), b0 = *(const f32x4*)(mb + PR_K), b1 = *(const f32x4*)(mb + PR_K + 4), c0 = *(const f32x4*)(mb + PR_V), c1 = *(const f32x4*)(mb + PR_V + 4);
              const f32x4 d0 = *(const f32x4*)(p->in[I_KK] + hc), d1 = *(const f32x4*)(p->in[I_KK] + hc + 4), e0 = *(const f32x4*)(p->in[I_KA] + hc), e1 = *(const f32x4*)(p->in[I_KA] + hc + 4), f0 = *(const f32x4*)(p->in[I_RK] + hc), f1 = *(const f32x4*)(p->in[I_RK] + hc + 4);
#pragma unroll
              for (int q = 0; q < 4; ++q) { mu_r[q] = a0[q]; mu_r[4 + q] = a1[q]; mu_k[q] = b0[q]; mu_k[4 + q] = b1[q]; mu_v[q] = c0[q]; mu_v[4 + q] = c1[q]; kks[q] = d0[q]; kks[4 + q] = d1[q]; ka[q] = e0[q]; ka[4 + q] = e1[q]; rk[q] = f0[q]; rk[4 + q] = f1[q]; } }
            unpack8(R.rc, rc); unpack8(R.kc, kc); unpack8(R.vc, vc); unpack8(R.rp, rp); unpack8(R.kp, kp); unpack8(R.vp, vp); unpack8(R.e, e); unpack8(R.a, a);
            float n2 = 0.f, cc = 0.f;
#pragma unroll
            for (int q = 0; q < 8; ++q) { r[q] = rc[q] + mu_r[q] * (rp[q] - rc[q]); k[q] = kc[q] + mu_k[q] * (kp[q] - kc[q]); v[q] = vc[q] + mu_v[q] * (vp[q] - vc[q]);
                w[q] = __builtin_amdgcn_exp2f(-1.4426950408889634f * e[q]); kk[q] = k[q] * kks[q]; n2 += kk[q] * kk[q];
                kq[q] = k[q] * (1.f + (a[q] - 1.f) * ka[q]); cc += r[q] * kq[q] * rk[q]; }
            n2 = red8(n2); cc = red8(cc); const float inv = 1.f / fmaxf(sqrtf(n2), 1e-12f);
#pragma unroll
            for (int q = 0; q < 8; ++q) { kk[q] *= inv; bb[q] = kk[q] * a[q]; }
            *(LAS f32x4*)(dst) = (f32x4){r[0], r[1], r[2], r[3]}; *(LAS f32x4*)(dst + 4) = (f32x4){r[4], r[5], r[6], r[7]};
            *(LAS f32x4*)(dst + 64) = (f32x4){w[0], w[1], w[2], w[3]}; *(LAS f32x4*)(dst + 68) = (f32x4){w[4], w[5], w[6], w[7]};
            *(LAS f32x4*)(dst + 128) = (f32x4){kq[0], kq[1], kq[2], kq[3]}; *(LAS f32x4*)(dst + 132) = (f32x4){kq[4], kq[5], kq[6], kq[7]};
            *(LAS f32x4*)(dst + 192) = (f32x4){kk[0], kk[1], kk[2], kk[3]}; *(LAS f32x4*)(dst + 196) = (f32x4){kk[4], kk[5], kk[6], kk[7]};
            *(LAS f32x4*)(dst + 256) = (f32x4){bb[0], bb[1], bb[2], bb[3]}; *(LAS f32x4*)(dst + 260) = (f32x4){bb[4], bb[5], bb[6], bb[7]};
            *(LAS f32x4*)(dst + 320) = (f32x4){v[0], v[1], v[2], v[3]}; *(LAS f32x4*)(dst + 324) = (f32x4){v[4], v[5], v[6], v[7]};
            if (wr_c) Cc[((size_t)b * SEQ + c * TS + sl) * 32 + h] = cc; };
        const bool bg = (gridDim.x == 256); const int gidx = blockIdx.x * 4 + lw; LAS float* wl = lds + 2 * CHF + lw * 384;
        auto chunk_head = [&]() { asm volatile("s_waitcnt lgkmcnt(0)" ::: "memory");
            __builtin_amdgcn_s_barrier(); asm volatile("" ::: "memory"); };
        LdRegs R; load(0, R); process(0, R); load(1, R);
        auto chunk_tail = [&](int c) { if (c + 1 < NCH) { process(c + 1, R); if (c + 2 < NCH) load(c + 2, R); } };
        LAS float* tl = lds + 2 * CHF + 4 * 384 + (lw < 3 ? lw : 0) * (32 * 65);
        const int gw3 = blockIdx.x * 3 + lw;
        auto plain = [&](int ca, int cb) {
#pragma unroll 1
            for (int c = ca; c < cb; ++c) { chunk_head(); chunk_tail(c); } };
        auto conv_slot = [&](int c, int k) { const int u = gw3 + BGC_WAVES * k;
            if (bg && lw < 3 && u < BGC_TOTAL) { BgcRegs CR; bgc_load(p, u, CR, lane); chunk_head(); bgc_finish(p, u, CR, tl, lane); chunk_tail(c); }
            else { chunk_head(); chunk_tail(c); } };
#pragma unroll 1
        for (int seg = 0; seg < NCH / 16; ++seg) { const int c0 = seg * 16;
            plain(c0, c0 + 3);
            if (bg) { SmpRegs SR; const int item = gidx + 1024 * seg; smp_load(p, item, SR, lane); chunk_head(); smp_finish(p, item, SR, wl, lane); chunk_tail(c0 + 3); }
            else { chunk_head(); chunk_tail(c0 + 3); }
            plain(c0 + 4, c0 + 7);
            conv_slot(c0 + 7, seg * 2);
            plain(c0 + 8, c0 + 12);
            conv_slot(c0 + 12, seg * 2 + 1);
            plain(c0 + 13, c0 + 16);
        }
    } else {
        __builtin_amdgcn_s_setprio(3);
        const int rp = lane >> 4, cq = (lane & 15) * 4, i0 = half * 32 + wid * 8 + rp * 2;
        bf16_t* Y = (bf16_t*)(p->ws + WS_Y) + (size_t)b * SEQ * D + h * 64 + i0;
        f32x2 S0a = {0.f, 0.f}, S0b = {0.f, 0.f}, S1a = {0.f, 0.f}, S1b = {0.f, 0.f};
        const int lq = lane & 15;
        for (int c = 0; c < NCH; ++c) {
            __syncthreads();
            const LAS float* L = lds + (c & 1) * CHF;
            StepRegs nx; nx.ld(L, cq, i0);
#pragma unroll
            for (int g = 0; g < TS / 16; ++g) {
                float yk = 0.f;
#pragma unroll
                for (int s = 0; s < 16; ++s) {
                    const StepRegs cu = nx; L += 384;
                    if (s < 15 || g + 1 < TS / 16) nx.ld(L, cq, i0);
                    __builtin_amdgcn_sched_barrier(0x477);
                    const f32x4 r4 = cu.r, w4 = cu.w, k4 = cu.k, q4 = cu.q, b4 = cu.b; const f32x2 v2 = cu.v;
                    const f32x2 ra = {r4[0], r4[1]}, rb = {r4[2], r4[3]}, wa = {w4[0], w4[1]}, wb = {w4[2], w4[3]}, ka_ = {k4[0], k4[1]}, kb = {k4[2], k4[3]}, qa = {q4[0], q4[1]}, qb = {q4[2], q4[3]}, ba = {b4[0], b4[1]}, bb_ = {b4[2], b4[3]};
                    f32x2 t0 = __builtin_elementwise_fma(S0b, qb, S0a * qa), t1 = __builtin_elementwise_fma(S1b, qb, S1a * qa);
                    const float sa0 = -red16(t0[0] + t0[1]), sa1 = -red16(t1[0] + t1[1]);
                    const f32x2 sa0v = {sa0, sa0}, sa1v = {sa1, sa1}, v0v = {v2[0], v2[0]}, v1v = {v2[1], v2[1]};
                    S0a = __builtin_elementwise_fma(S0a, wa, __builtin_elementwise_fma(sa0v, ba, v0v * ka_)); S0b = __builtin_elementwise_fma(S0b, wb, __builtin_elementwise_fma(sa0v, bb_, v0v * kb));
                    S1a = __builtin_elementwise_fma(S1a, wa, __builtin_elementwise_fma(sa1v, ba, v1v * ka_)); S1b = __builtin_elementwise_fma(S1b, wb, __builtin_elementwise_fma(sa1v, bb_, v1v * kb));
                    t0 = __builtin_elementwise_fma(S0b, rb, S0a * ra); t1 = __builtin_elementwise_fma(S1b, rb, S1a * ra);
                    const float x0 = t0[0] + t0[1], x1 = t1[0] + t1[1];
                    const bool odd = lane & 1; float u = odd ? x1 : x0; const float vv = odd ? x0 : x1;
                    u += dppf<0xB1>(vv); u += dppf<0x4E>(u); u += dppf<0x124>(u); u += dppf<0x128>(u);
                    yk = ((lq >> 1) == (s & 7)) ? u : yk;
                    if ((s & 7) == 7) Y[(size_t)(c * TS + g * 16 + (s - 7) + (lq >> 1)) * D + (lq & 1)] = f2bf(yk);
                }
            }
        }
        __builtin_amdgcn_s_setprio(0);
        float* so = p->out + O_WKVP + ((size_t)(b * 32 + h) * 64 + i0) * 64 + cq;
        *(f32x4*)so = (f32x4){S0a[0], S0a[1], S0b[0], S0b[1]}; *(f32x4*)(so + 64) = (f32x4){S1a[0], S1a[1], S1b[0], S1b[1]};
    }
    __syncthreads();
}
__device__ void phase4(PP p, LAS unsigned char* lds) {
    REP(4) for (int it = blockIdx.x; it < 256; it += gridDim.x) scan_prompt_item(p, it, (LAS float*)lds);
    const int wid = __builtin_amdgcn_readfirstlane(tid_opaque() >> 6);
    if (gridDim.x != 256) for (int it = blockIdx.x * 8 + wid; it < 4096; it += gridDim.x * 8) scan_sample_item(p, it, (LAS float*)lds + wid * 384);
}

__device__ void phase5(PP p) {
    const int tid = tid_opaque(), lane = tid & 63, gw = blockIdx.x * 8 + (tid >> 6), nw = gridDim.x * 8;
    const bf16_t* PROJ = (const bf16_t*)(p->ws + WS_PROJ); const bf16_t* Y = (const bf16_t*)(p->ws + WS_Y); const float* Cc = (const float*)(p->ws + WS_C); bf16_t* YB = (bf16_t*)(p->ws + WS_YB);
    f32x4 pmu[4][2], pg[4][2], pb[4][2];
#pragma unroll
    for (int q = 0; q < 4; ++q) { const int c0 = q * 512 + lane * 8;
#pragma unroll
        for (int hh = 0; hh < 2; ++hh) { pmu[q][hh] = *(const f32x4*)(p->in[I_MU] + PR_V + c0 + hh * 4); pg[q][hh] = *(const f32x4*)(p->in[I_GNG] + c0 + hh * 4); pb[q][hh] = *(const f32x4*)(p->in[I_GNB] + c0 + hh * 4); } }
    for (int row = gw; row < NTOK_P; row += nw) { const bool first = (row & (SEQ - 1)) == 0; const bf16_t* pr = PROJ + (size_t)row * LDP;
        u32x4 yr[4], vcr[4], vpr[4], zbr[4]; float ccs[4];
#pragma unroll
        for (int q = 0; q < 4; ++q) { const int c0 = q * 512 + lane * 8;
            yr[q] = *(const u32x4*)(Y + (size_t)row * D + c0);
            vcr[q] = *(const u32x4*)(pr + C_PR + PR_V + c0); vpr[q] = first ? (u32x4){0u, 0u, 0u, 0u} : *(const u32x4*)(pr - LDP + C_PR + PR_V + c0);
            zbr[q] = *(const u32x4*)(pr + C_ZB + c0); ccs[q] = Cc[(size_t)row * 32 + (c0 >> 6)]; }
#pragma unroll
        for (int q = 0; q < 4; ++q) { const int c0 = q * 512 + lane * 8; float y[8], vc[8], vp[8], zb[8], f[8];
            unpack8(yr[q], y);
            float s = 0.f;
#pragma unroll
            for (int k = 0; k < 8; ++k) s += y[k];
            const float m = red8(s) * (1.f / 64.f); float s2 = 0.f;
#pragma unroll
            for (int k = 0; k < 8; ++k) { y[k] -= m; s2 += y[k] * y[k]; }
            const float rstd = rsqrtf(red8(s2) * (1.f / 64.f) + 64e-5f);
            unpack8(vcr[q], vc); unpack8(vpr[q], vp); unpack8(zbr[q], zb);
#pragma unroll
            for (int k = 0; k < 8; ++k) { const float v = vc[k] + pmu[q][k >> 2][k & 3] * (vp[k] - vc[k]);
                f[k] = (y[k] * rstd * pg[q][k >> 2][k & 3] + pb[q][k >> 2][k & 3] + ccs[q] * v) * zb[k]; }
            *(u32x4*)(YB + (size_t)row * D + c0) = pack8(f); } }
    for (int idx = blockIdx.x * 512 + tid; idx < NMODROW * SHIFT_W; idx += gridDim.x * 512) { const int rr = idx / SHIFT_W, k = idx % SHIFT_W;
        const size_t srow = rr < 4 ? (size_t)rr * SEQ + SEQ - 1 : (size_t)NTOK_P + rr - 4;
        const float v = bf2f(PROJ[srow * LDP + C_PR + k]);
        if (rr < 4) p->out[O_SHP + (size_t)rr * SHIFT_W + k] = v; else p->out[O_SHS + (size_t)(rr - 4) * SHIFT_W + k] = v; }
}

__device__ void phase9(PP p) {
    const int tid = tid_opaque(), lane = tid & 63, gw = blockIdx.x * 8 + (tid >> 6), nw = gridDim.x * 8; const float* fg = p->in[I_FG];
    const bf16_t* OB = (const bf16_t*)(p->ws + WS_Y);
    f32x4 g[4][2]; u32x4 v[4], vn[4];
#pragma unroll
    for (int i = 0; i < 4; ++i) { g[i][0] = *(const f32x4*)(fg + (lane + 64 * i) * 8); g[i][1] = *(const f32x4*)(fg + (lane + 64 * i) * 8 + 4); }
    if (gw < NTOK) {
#pragma unroll
        for (int i = 0; i < 4; ++i) v[i] = *(const u32x4*)(OB + (size_t)gw * D + (lane + 64 * i) * 8); }
    for (int r = gw; r < NTOK; r += nw) { float* o = p->out + O_Y + (size_t)r * D; const int rn = r + nw;
        if (rn < NTOK) {
#pragma unroll
            for (int i = 0; i < 4; ++i) vn[i] = *(const u32x4*)(OB + (size_t)rn * D + (lane + 64 * i) * 8); }
        float f[4][8]; float ss = 0.f;
#pragma unroll
        for (int i = 0; i < 4; ++i) { unpack8(v[i], f[i]);
#pragma unroll
            for (int q = 0; q < 8; ++q) ss += f[i][q] * f[i][q]; }
        ss = wave_sum(ss); const float rstd = rsqrtf(ss * (1.f / D) + 1e-6f);
#pragma unroll
        for (int i = 0; i < 4; ++i) { const int c = (lane + 64 * i) * 8;
            *(f32x4*)(o + c) = (f32x4){f[i][0], f[i][1], f[i][2], f[i][3]} * rstd * g[i][0]; *(f32x4*)(o + c + 4) = (f32x4){f[i][4], f[i][5], f[i][6], f[i][7]} * rstd * g[i][1]; }
#pragma unroll
        for (int i = 0; i < 4; ++i) v[i] = vn[i];
    }
}

#ifndef DBG_STOP
#define DBG_STOP 99
#endif
__device__ void dbg_dump(PP p) {
    const size_t n = O_CV + 128 * 1024, gt = (size_t)blockIdx.x * 512 + tid_opaque(), gs = (size_t)gridDim.x * 512;
    const bf16_t* w = (const bf16_t*)p->ws;
    for (size_t i = gt; i < n; i += gs) {
        float a = 0.f;
        if (DBG_STOP == 2) { const bf16_t* q = w + WS_PROJ / 2; for (int k = 0; k < 3; ++k) a += bf2f(q[i + (size_t)k * n]); }
        if (DBG_STOP == 1) { const bf16_t* q = w + WS_H / 2; a = bf2f(q[i % ((size_t)MP * D)]); }
        if (DBG_STOP == 0) { const bf16_t* q = w + WS_WTIN / 2; a = bf2f(q[i % ((size_t)LDP * D)]) + bf2f(q[(i + n) % ((size_t)LDP * D)]) + ((const float*)(p->ws + WS_MOD))[i % (NMODROW * 6144)]; }
        if (DBG_STOP == 3) { a = bf2f(w[WS_E / 2 + i % ((size_t)NTOK * D)]) + bf2f(w[WS_AAA / 2 + i % ((size_t)NTOK * D)]) + bf2f(w[WS_YA / 2 + i % ((size_t)NTOK * A_W)]); }
        if (DBG_STOP == 4) { a = bf2f(((const bf16_t*)(p->ws + WS_Y))[i % ((size_t)NTOK_P * D)]) + ((const float*)(p->ws + WS_C))[i % (NTOK_P * 32)]; if (i >= O_WKVP) continue; }
        if (DBG_STOP == 5) { a = bf2f(w[WS_YB / 2 + i % ((size_t)NTOK * D)]); if (i >= O_WKVP) continue; }
        if (DBG_STOP == 7) { a = bf2f(w[WS_MRG / 2 + i % ((size_t)NTOK * D)]); if (i >= O_WKVP) continue; }
        p->out[i] = a;
    }
}

constexpr int NPHASE = 10, LDS_BYTES = 131072 + 16;
__global__ void __launch_bounds__(512) mega(P p_) {
    extern __shared__ __attribute__((aligned(16))) unsigned char shm[];
    LAS unsigned char* lds = (LAS unsigned char*)shm;
    PP p0 = (PP)__builtin_amdgcn_kernarg_segment_ptr();
    const int ph_lo = p0->ph_lo, ph_hi = p0->ph_hi;
    volatile LAS unsigned* st = (volatile LAS unsigned*)(lds + 131072);
    if (threadIdx.x == 0) { st[0] = 0u; st[1] = 0u; st[2] = 0u; st[3] = 0u; }
    __syncthreads();
    const XcdBarrier xb = xcd_barrier_post((unsigned*)(p0->ws + WS_BAR), st);
#ifndef PH_MASK
#define PH_MASK 0x3ff
#endif
#define GSYNC() xcd_barrier(xb)
#define PHASE(n) if (((PH_MASK >> (n)) & 1) && (n) <= DBG_STOP && ph_lo <= (n) && (n) < ph_hi) { if ((n) > ph_lo) GSYNC(); PP p = p0; asm volatile("" : "+s"(p));
#define PHASE_NOSYNC(n) if (((PH_MASK >> (n)) & 1) && (n) <= DBG_STOP && ph_lo <= (n) && (n) < ph_hi) { PP p = p0; asm volatile("" : "+s"(p));
#define PHASE_END }
    PHASE(0) REP(0) { phase0(p, lds); __syncthreads(); } PHASE_END
    PHASE(1) REP(1) phase1(p); PHASE_END
    PHASE(2) REP(2) { pg8::Gemm g{(const bf16_t*)(p->ws + WS_H), (const bf16_t*)(p->ws + WS_WTIN), MP, LDP, D}; pg8::StaticOrder S; S.init(MP, LDP, gridDim.x, blockIdx.x);
        EpiProj E{(bf16_t*)(p->ws + WS_PROJ)}; pg8::gemm_phase(lds, g, S, E); } PHASE_END
#ifdef EXTRA_SYNCS
    for (int i_ = 0; i_ < EXTRA_SYNCS; ++i_) GSYNC();
#endif
    PHASE(3) REP(3) { phase3(p, lds); __syncthreads(); } PHASE_END
    PHASE(4) phase4(p, lds); PHASE_END
    PHASE(5) REP(5) phase5(p); PHASE_END
    PHASE(6) REP(6) { pg8::Gemm g{(const bf16_t*)(p->ws + WS_YA), (const bf16_t*)(p->ws + WS_WTPA), NTOK_P, D, A_W}; pg8::StaticOrder S; S.init(NTOK_P, D, gridDim.x, blockIdx.x);
        EpiMerge<false> E{(bf16_t*)(p->ws + WS_MRG), (const bf16_t*)(p->ws + WS_PROJ) + C_GA}; pg8::gemm_phase(lds, g, S, E);
        bf16_t* mrg = (bf16_t*)(p->ws + WS_MRG) + (size_t)NTOK_P * D; const bf16_t* gp = (const bf16_t*)(p->ws + WS_PROJ) + (size_t)NTOK_P * LDP + C_GA;
        small_gemm((const bf16_t*)(p->ws + WS_YA) + (size_t)NTOK_P * A_W, (const bf16_t*)(p->ws + WS_WTPA), A_W, (LAS float*)lds, [&](const f32x4 acc, int r, int c) {
            const u32x2 g2 = *(const u32x2*)(gp + (size_t)r * LDP + c); u32x2 o; o[0] = cvt_pk_bf16(acc[0] * bflo(g2[0]), acc[1] * bfhi(g2[0])); o[1] = cvt_pk_bf16(acc[2] * bflo(g2[1]), acc[3] * bfhi(g2[1]));
            *(u32x2*)(mrg + (size_t)r * D + c) = o; }); } PHASE_END
    PHASE_NOSYNC(7) { pg8::Gemm g{(const bf16_t*)(p->ws + WS_YB), (const bf16_t*)(p->ws + WS_WTPB), NTOK_P, D, B_W}; pg8::StaticOrder S; S.init(NTOK_P, D, gridDim.x, blockIdx.x);
        EpiMerge<true> E{(bf16_t*)(p->ws + WS_MRG), (const bf16_t*)(p->ws + WS_PROJ) + C_GB}; pg8::gemm_phase(lds, g, S, E);
        bf16_t* mrg = (bf16_t*)(p->ws + WS_MRG) + (size_t)NTOK_P * D; const bf16_t* gp = (const bf16_t*)(p->ws + WS_PROJ) + (size_t)NTOK_P * LDP + C_GB;
        small_gemm((const bf16_t*)(p->ws + WS_YB) + (size_t)NTOK_P * B_W, (const bf16_t*)(p->ws + WS_WTPB), B_W, (LAS float*)lds, [&](const f32x4 acc, int r, int c) {
            const u32x2 g2 = *(const u32x2*)(gp + (size_t)r * LDP + c), m2 = *(const u32x2*)(mrg + (size_t)r * D + c); u32x2 o;
            o[0] = cvt_pk_bf16(bflo(m2[0]) + acc[0] * bflo(g2[0]), bfhi(m2[0]) + acc[1] * bfhi(g2[0])); o[1] = cvt_pk_bf16(bflo(m2[1]) + acc[2] * bflo(g2[1]), bfhi(m2[1]) + acc[3] * bfhi(g2[1]));
            *(u32x2*)(mrg + (size_t)r * D + c) = o; }); } PHASE_END
    PHASE(8) REP(8) { pg8::Gemm g{(const bf16_t*)(p->ws + WS_MRG), (const bf16_t*)(p->ws + WS_WTOUT), NTOK_P, D, D}; pg8::StaticOrder S; S.init(NTOK_P, D, gridDim.x, blockIdx.x);
        EpiOut E{(bf16_t*)(p->ws + WS_Y), p->in[I_XP], p->in[I_XS], (const float*)(p->ws + WS_MOD)}; pg8::gemm_phase(lds, g, S, E);
        bf16_t* os = (bf16_t*)(p->ws + WS_Y) + (size_t)NTOK_P * D; const float* xs = p->in[I_XS]; const float* gate = (const float*)(p->ws + WS_MOD) + (size_t)4 * 6144 + 4096;
        small_gemm((const bf16_t*)(p->ws + WS_MRG) + (size_t)NTOK_P * D, (const bf16_t*)(p->ws + WS_WTOUT), D, (LAS float*)lds, [&](const f32x4 acc, int r, int c) {
            const f32x4 o = *(const f32x4*)(xs + (size_t)r * D + c) + *(const f32x4*)(gate + (size_t)r * 6144 + c) * acc; u32x2 ob; ob[0] = cvt_pk_bf16(o[0], o[1]); ob[1] = cvt_pk_bf16(o[2], o[3]);
            *(u32x2*)(os + (size_t)r * D + c) = ob; }); } PHASE_END
    PHASE(9) phase9(p); PHASE_END
    if (DBG_STOP < 9) { GSYNC(); PP p = p0; asm volatile("" : "+s"(p)); dbg_dump(p); }
}

extern "C" void kernel_launch(void* const* d_in, const int* in_sizes, int n_in, void* d_out, int out_size, void* d_ws, size_t ws_size, hipStream_t stream) {
    static int grid_blocks = 0;
    if (grid_blocks == 0) {
        if (n_in != 28 || ws_size < WS_END) { fprintf(stderr, "kernel_launch: unexpected n_in %d or ws_size %zu (need %zu)\n", n_in, ws_size, (size_t)WS_END); grid_blocks = -1; return; }
        int dev = 0, cus = 0, per_cu = 0;
        (void)hipGetDevice(&dev);
        (void)hipDeviceGetAttribute(&cus, hipDeviceAttributeMultiprocessorCount, dev);
        if (hipFuncSetAttribute((const void*)mega, hipFuncAttributeMaxDynamicSharedMemorySize, LDS_BYTES) != hipSuccess) { fprintf(stderr, "kernel_launch: hipFuncSetAttribute failed\n"); grid_blocks = -1; return; }
        if (hipOccupancyMaxActiveBlocksPerMultiprocessor(&per_cu, (const void*)mega, 512, LDS_BYTES) != hipSuccess || per_cu < 1) { fprintf(stderr, "kernel_launch: occupancy query failed (%d)\n", per_cu); grid_blocks = -1; return; }
        grid_blocks = cus * per_cu;
    }
    if (grid_blocks < 0) return;
    if (hipMemsetAsync((unsigned char*)d_ws + WS_BAR, 0, XCD_BAR_WORDS_C * 4, stream) != hipSuccess) { fprintf(stderr, "kernel_launch: memset of barrier words failed\n"); return; }
    P p{};
    for (int i = 0; i < 28; ++i) p.in[i] = (const float*)d_in[i];
    p.out = (float*)d_out; p.ws = (unsigned char*)d_ws;
#if N_LAUNCH_PER_PHASE
    for (int ph = 0; ph < NPHASE; ++ph) { p.ph_lo = ph; p.ph_hi = ph + 1; void* args[] = {&p};
        hipError_t e = hipLaunchCooperativeKernel((const void*)mega, dim3(grid_blocks), dim3(512), args, LDS_BYTES, stream);
        if (e != hipSuccess) { fprintf(stderr, "cooperative launch failed: %s (grid %d)\n", hipGetErrorString(e), grid_blocks); return; } }
#else
    p.ph_lo = 0; p.ph_hi = NPHASE; void* args[] = {&p};
    hipError_t e = hipLaunchCooperativeKernel((const void*)mega, dim3(grid_blocks), dim3(512), args, LDS_BYTES, stream);
    if (e != hipSuccess) fprintf(stderr, "cooperative launch failed: %s (grid %d)\n", hipGetErrorString(e), grid_blocks);
#endif
}
```

```cpp
#include <hip/hip_runtime.h>
#include <cstdio>

#ifndef REP_MASK
#define REP_MASK 0
#endif
#define REP(n) for (int rep_ = 0; rep_ < (((REP_MASK >> (n)) & 1) ? 2 : 1); ++rep_)
#ifndef N_LAUNCH_PER_PHASE
#define N_LAUNCH_PER_PHASE 0
#endif

#define LAS __attribute__((address_space(3)))
typedef unsigned short bf16_t;
typedef short bf16x8 __attribute__((ext_vector_type(8)));
typedef float f32x4 __attribute__((ext_vector_type(4)));
typedef float f32x2 __attribute__((ext_vector_type(2)));
typedef unsigned u32x4 __attribute__((ext_vector_type(4)));
typedef unsigned u32x2 __attribute__((ext_vector_type(2)));

constexpr int D = 2048, NTOK_P = 8192, NTOK_S = 128, NTOK = 8320, MP = 8448, SEQ = 2048;
constexpr int A_W = 1024, B_W = 2048, SHIFT_W = 6336, IN_W = 15552;
constexpr int LDP = 15616;
constexpr int C_UA = 0, C_VA = 1024, C_ZA = 2048, C_PR = 3072, C_ZB = 9472, C_GA = 11520, C_GB = 13568;
constexpr int PR_R = 0, PR_WD = 2048, PR_K = 2144, PR_V = 4192, PR_AD = 6240;
constexpr int NMODROW = 132, XCD_BAR_WORDS_C = 3456;

constexpr size_t SZ_WTIN = (size_t)LDP * D * 2, SZ_H = (size_t)MP * D * 2;
constexpr size_t WS_WTIN = 0, WS_H = WS_WTIN + SZ_WTIN;
constexpr size_t WS_E = 0, WS_AAA = WS_E + (size_t)NTOK * D * 2, WS_YA = WS_AAA + (size_t)NTOK * D * 2, WS_YB = 0;
constexpr size_t WS_PROJ = WS_H + SZ_H, SZ_PROJ = (size_t)MP * LDP * 2;
constexpr size_t WS_WTPA = WS_PROJ + SZ_PROJ, WS_WTPB = WS_WTPA + (size_t)D * A_W * 2, WS_WTOUT = WS_WTPB + (size_t)D * B_W * 2;
constexpr size_t WS_W2T = WS_WTOUT + (size_t)D * D * 2, WS_A2T = WS_W2T + (size_t)B_W * 96 * 2;
constexpr size_t WS_MOD = WS_A2T + (size_t)B_W * 96 * 2, WS_C = WS_MOD + (size_t)NMODROW * 6144 * 4;
constexpr size_t WS_Y = WS_C + (size_t)NTOK_P * 32 * 4, WS_MRG = WS_Y + (size_t)NTOK_P * D * 4, WS_ES = WS_MRG + SZ_H, WS_BAR = WS_ES + (size_t)NTOK_S * D * 2, WS_END = WS_BAR + XCD_BAR_WORDS_C * 4;
static_assert(WS_YA + (size_t)MP * A_W * 2 <= WS_PROJ, "alias region overflow");

constexpr size_t O_Y = 0, O_WKVP = (size_t)NTOK * D, O_SHP = O_WKVP + 4 * 32 * 4096, O_WKVS = O_SHP + 4 * SHIFT_W, O_SHS = O_WKVS + (size_t)128 * 32 * 4096,
                 O_CV = O_SHS + (size_t)128 * SHIFT_W;

struct P {
    const float* in[28];
    float* out;
    unsigned char* ws;
    int ph_lo, ph_hi;
};
typedef const __attribute__((address_space(4))) P* PP;
enum { I_XP = 0, I_XS, I_CP, I_CS, I_SWKV, I_SSH, I_NORMG, I_WC, I_BC, I_WIN, I_LNG, I_LNB, I_WS, I_BS, I_MU, I_W0, I_W2, I_A0, I_A2, I_KK, I_KA, I_RK, I_GNG, I_GNB,
       I_PA, I_PB, I_WOUT, I_FG };

typedef __bf16 bf16x2_t __attribute__((ext_vector_type(2)));
__device__ __forceinline__ unsigned cvt_pk_bf16(float lo, float hi) { const f32x2 v = {lo, hi}; const bf16x2_t b = __builtin_convertvector(v, bf16x2_t); return __builtin_bit_cast(unsigned, b); }
__device__ __forceinline__ bf16_t f2bf(float f) { return (bf16_t)(cvt_pk_bf16(f, 0.f) & 0xffffu); }
__device__ __forceinline__ float bf2f(bf16_t b) { return __uint_as_float(((unsigned)b) << 16); }
__device__ __forceinline__ float bflo(unsigned u) { return __uint_as_float(u << 16); }
__device__ __forceinline__ float bfhi(unsigned u) { return __uint_as_float(u & 0xffff0000u); }
__device__ __forceinline__ int tid_opaque() { int t = threadIdx.x; asm volatile("" : "+v"(t)); return t; }
template <int CTRL> __device__ __forceinline__ float dppf(float x) { return __int_as_float(__builtin_amdgcn_update_dpp(0, __float_as_int(x), CTRL, 0xf, 0xf, false)); }
__device__ __forceinline__ float red8(float x) { x += dppf<0xB1>(x); x += dppf<0x4E>(x); x += dppf<0x141>(x); return x; }
__device__ __forceinline__ float wave_sum(float v) {
    v += dppf<0xB1>(v); v += dppf<0x4E>(v); v += dppf<0x141>(v); v += dppf<0x140>(v);
    const int iv = __float_as_int(v);
    return (__int_as_float(__builtin_amdgcn_readlane(iv, 0)) + __int_as_float(__builtin_amdgcn_readlane(iv, 16))) + (__int_as_float(__builtin_amdgcn_readlane(iv, 32)) + __int_as_float(__builtin_amdgcn_readlane(iv, 48)));
}
__device__ __forceinline__ float sigmoid_f(float x) { return __builtin_amdgcn_rcpf(1.f + __builtin_amdgcn_exp2f(-1.4426950408889634f * x)); }
__device__ __forceinline__ float tanh_fast(float x) { return 1.f - 2.f * __builtin_amdgcn_rcpf(1.f + __builtin_amdgcn_exp2f(2.8853900817779268f * x)); }
__device__ __forceinline__ float gelu_tanh_f(float x) { return x * sigmoid_f(1.5957691216057308f * (x + 0.044715f * x * x * x)); }
__device__ __forceinline__ float silu_f(float x) { return x * sigmoid_f(x); }
__device__ __forceinline__ void unpack8(const u32x4 r, float (&f)[8]) {
    f[0] = bflo(r[0]); f[1] = bfhi(r[0]); f[2] = bflo(r[1]); f[3] = bfhi(r[1]); f[4] = bflo(r[2]); f[5] = bfhi(r[2]); f[6] = bflo(r[3]); f[7] = bfhi(r[3]);
}
__device__ __forceinline__ u32x4 pack8(const float (&f)[8]) { u32x4 r; r[0] = cvt_pk_bf16(f[0], f[1]); r[1] = cvt_pk_bf16(f[2], f[3]); r[2] = cvt_pk_bf16(f[4], f[5]); r[3] = cvt_pk_bf16(f[6], f[7]); return r; }


#define XB_TMO      128
#define XB_XCNT(j)  (256  + 64 * (j))
#define XB_XSUB(j)  (1280 + 64 * (j))
#define XB_XGEN(j)  (2304 + 64 * (j))
#define XB_TOP      3328
#define XB_TOPGEN   3392
#define XCD_BAR_WORDS 3456
#define XB_SPIN_CAP (1u << 18)
__device__ __forceinline__ unsigned xb_ld(unsigned* p)              { return __hip_atomic_load(p, __ATOMIC_RELAXED, __HIP_MEMORY_SCOPE_AGENT); }
__device__ __forceinline__ unsigned xb_add(unsigned* p, unsigned v) { return __hip_atomic_fetch_add(p, v, __ATOMIC_RELAXED, __HIP_MEMORY_SCOPE_AGENT); }
__device__ __forceinline__ unsigned xb_xcc_id() { return (unsigned)__builtin_amdgcn_s_getreg((3 << 11) | 20) & 0xFu; }
#define XB_SPIN(cond, bar) do { unsigned _sp = 0; while (cond) { __builtin_amdgcn_s_sleep(1); \
    if ((++_sp & 255u) == 0u) { if (xb_ld(&(bar)[XB_TMO])) break; if (_sp > XB_SPIN_CAP) { atomicAdd(&(bar)[XB_TMO], 1u); break; } } } } while (0)
struct XcdBarrier { unsigned* bar; unsigned x; volatile LAS unsigned* st; };
__device__ __forceinline__ XcdBarrier xcd_barrier_post(unsigned* bar, volatile LAS unsigned* st) {
    XcdBarrier b; b.bar = bar; b.x = xb_xcc_id(); b.st = st;
    if (threadIdx.x == 0) (void)xb_add(&bar[XB_XCNT(b.x)], 1u);
    return b;
}
__device__ __forceinline__ void xcd_barrier_complete(unsigned* bar, unsigned x, unsigned& nloc, unsigned& nx) {
    const unsigned G = gridDim.x * gridDim.y * gridDim.z;
    unsigned sum, cnt, mine, sp = 0u;
    for (;;) {
        sum = 0u; cnt = 0u; mine = 0u;
#pragma unroll
        for (unsigned j = 0; j < 16; ++j) { const unsigned c = xb_ld(&bar[XB_XCNT(j)]); sum += c; cnt += (c > 0u) ? 1u : 0u; mine = (j == x) ? c : mine; }
        if (sum == G) break;
        __builtin_amdgcn_s_sleep(1);
        if ((++sp & 255u) == 0u) { if (xb_ld(&bar[XB_TMO])) break; if (sp > XB_SPIN_CAP) { atomicAdd(&bar[XB_TMO], 1u); break; } }
    }
    nloc = mine > 0u ? mine : 1u; nx = cnt > 0u ? cnt : 1u;
}
__device__ __forceinline__ void xcd_barrier(const XcdBarrier& b) {
    asm volatile("s_waitcnt vmcnt(0)" ::: "memory");
    __syncthreads();
    if (threadIdx.x == 0) {
        unsigned* bar = b.bar;
        __builtin_amdgcn_s_waitcnt(0);
        unsigned nloc = b.st[0], nx = b.st[1];
        if (nloc == 0u) { xcd_barrier_complete(bar, b.x, nloc, nx); b.st[0] = nloc; b.st[1] = nx; }
        const unsigned old = xb_add(&bar[XB_XSUB(b.x)], 1u);
        const unsigned gen = old / nloc;
        if (old + 1u == (gen + 1u) * nloc) {
            __builtin_amdgcn_fence(__ATOMIC_RELEASE, "agent");
            asm volatile("s_waitcnt vmcnt(0)" ::: "memory");
            const unsigned og = xb_add(&bar[XB_TOP], 1u);
            const unsigned tg = og / nx;
            if (og + 1u == (tg + 1u) * nx) xb_add(&bar[XB_TOPGEN], 1u);
            else XB_SPIN(xb_ld(&bar[XB_TOPGEN]) == tg, bar);
            __builtin_amdgcn_fence(__ATOMIC_ACQUIRE, "agent");
            xb_add(&bar[XB_XGEN(b.x)], 1u);
            asm volatile("s_waitcnt vmcnt(0)" ::: "memory");
        } else {
            XB_SPIN(xb_ld(&bar[XB_XGEN(b.x)]) == gen, bar);
            __builtin_amdgcn_fence(__ATOMIC_ACQUIRE, "agent");
            asm volatile("s_waitcnt vmcnt(0)" ::: "memory");
        }
    }
    __syncthreads();
}

namespace pg8 {
constexpr int BM = 256, BK = 64, HALF = 128, HTB = HALF * BK * 2, STAGE_BYTES = 8 * HTB, NXCD = 8, WGM = 2;
__device__ __forceinline__ int lds_byte(int r, int c) { const int st = (r >> 4) * 2 + (c >> 5), rr = r & 15, cc = c & 31, ob = rr * 64 + cc * 2; return st * 1024 + (ob ^ (((ob >> 9) & 1) << 5)); }
__device__ __forceinline__ void stage_rc(int b, int& R, int& C) { const int st = b / 1024, sb = b % 1024, swz = sb ^ (((sb >> 9) & 1) << 5); R = (st >> 1) * 16 + swz / 64; C = (st & 1) * 32 + (swz % 64) / 2; }
__device__ __forceinline__ int perm32(int rho) { const int n = rho >> 4, i = rho & 15; return 8 * (i >> 2) + 4 * n + (i & 3); }
struct Unit { int pm, pn; };
struct Gemm { const bf16_t* A; const bf16_t* Bt; int M, N, K; };
struct StaticOrder {
    int nM, nN, nwg, G, c;
    __device__ void init(int M, int N, int G_, int c_) { nM = M / BM; nN = N / BM; nwg = nM * nN; G = G_; c = c_; }
    __device__ bool next(int i, Unit& u) const {
        const long L = (long)i * G + c; if (L >= nwg) return false;
        int wgid = (int)L; { const int q = nwg / NXCD, r = nwg % NXCD, xcd = wgid % NXCD, off = wgid / NXCD; wgid = (xcd < r ? xcd * (q + 1) : r * (q + 1) + (xcd - r) * q) + off; }
        const int nig = WGM * nN, gid = wgid / nig, fm = gid * WGM, gsz = (nM - fm) < WGM ? (nM - fm) : WGM;
        u.pm = fm + ((wgid % nig) % gsz); u.pn = (wgid % nig) / gsz; return true;
    }
};

template <class Epi>
__device__ __forceinline__ void gemm_phase(LAS unsigned char* lds, const Gemm g, const StaticOrder& S, const Epi& E) {
    const int tid = tid_opaque(), wid = __builtin_amdgcn_readfirstlane(tid >> 6), lane = tid & 63, wr = wid >> 2, wc = wid & 3, fr = lane & 15, fq = lane >> 4;
    const int K = g.K, nt = K / BK;
    unsigned voffA[2], voffB[2];
#pragma unroll
    for (int i = 0; i < 2; ++i) { int R, C; stage_rc(tid * 16 + i * 8192, R, C); const int Rb = Epi::PERM ? ((R & ~31) + perm32(R & 31)) : R;
        voffA[i] = (unsigned)(R * K + C) * 2u; voffB[i] = (unsigned)(Rb * K + C) * 2u; }
    const size_t kstep = (size_t)(BK * 2);
    const size_t hstep = (size_t)HALF * K * 2;
    const size_t tstep = 2 * hstep;
    const unsigned ldsw = (unsigned)wid * 1024u;
    const int aoff = lds_byte(wr * 64 + fr, fq * 8), boff = lds_byte(wc * 32 + fr, fq * 8);
#define PG8_SA(b, h) (((b) * 2 + (h)) * HTB)
#define PG8_SB(b, h) ((4 + (b) * 2 + (h)) * HTB)
#define PG8_STAGE(bufoff, gbase, voff) do { _Pragma("unroll") for (int _i = 0; _i < 2; ++_i) \
        __builtin_amdgcn_global_load_lds((const unsigned*)((const char*)(gbase) + (voff)[_i]), (LAS unsigned*)(lds + (bufoff) + ldsw + _i * 8192), 16, 0, 0); } while (0)
#define PG8_LDA(dst, b, h) do { _Pragma("unroll") for (int m = 0; m < 4; ++m) _Pragma("unroll") for (int k = 0; k < 2; ++k) dst[m][k] = *(const LAS bf16x8*)(lds + PG8_SA(b, h) + aoff + m * 2048 + k * 1024); } while (0)
#define PG8_LDB(dst, b, h) do { _Pragma("unroll") for (int n = 0; n < 2; ++n) _Pragma("unroll") for (int k = 0; k < 2; ++k) dst[n][k] = *(const LAS bf16x8*)(lds + PG8_SB(b, h) + boff + n * 2048 + k * 1024); } while (0)
#define PG8_MMA(ai, bj, At, Bt) do { __builtin_amdgcn_s_setprio(1); _Pragma("unroll") for (int m = 0; m < 4; ++m) _Pragma("unroll") for (int n = 0; n < 2; ++n) _Pragma("unroll") for (int k = 0; k < 2; ++k) \
        acc[ai][bj][m][n] = __builtin_amdgcn_mfma_f32_16x16x32_bf16(Bt[n][k], At[m][k], acc[ai][bj][m][n], 0, 0, 0); __builtin_amdgcn_s_setprio(0); } while (0)
#define PG8_WAIT_V(n) asm volatile("s_waitcnt vmcnt(" #n ")" ::: "memory")
#define PG8_WAIT_L(n) asm volatile("s_waitcnt lgkmcnt(" #n ")" ::: "memory")
#define PG8_BAR __builtin_amdgcn_s_barrier()
#define PG8_SCHED __builtin_amdgcn_sched_barrier(0)
    Unit cur, nxt; int ui = 0;
    if (!S.next(0, cur)) return;
    f32x4 acc[2][2][4][2];
#pragma unroll
    for (int a = 0; a < 2; ++a)
#pragma unroll
        for (int b = 0; b < 2; ++b)
#pragma unroll
            for (int m = 0; m < 4; ++m)
#pragma unroll
                for (int n = 0; n < 2; ++n) acc[a][b][m][n] = (f32x4){0.f, 0.f, 0.f, 0.f};
    bf16x8 At[4][2], B0[2][2], B1[2][2];
    const char* cA = (const char*)g.A + (size_t)cur.pm * tstep; const char* cB = (const char*)g.Bt + (size_t)cur.pn * tstep;
    PG8_STAGE(PG8_SB(0, 0), cB, voffB); PG8_STAGE(PG8_SA(0, 0), cA, voffA); PG8_STAGE(PG8_SB(0, 1), cB + hstep, voffB); PG8_STAGE(PG8_SA(0, 1), cA + hstep, voffA);
    if (wr == 1) PG8_BAR;
    PG8_WAIT_V(4); PG8_BAR;
    PG8_STAGE(PG8_SB(1, 0), cB + kstep, voffB); PG8_STAGE(PG8_SA(1, 0), cA + kstep, voffA); PG8_STAGE(PG8_SB(1, 1), cB + hstep + kstep, voffB);
    PG8_WAIT_V(6); PG8_BAR;
    for (;;) {
        const bool has_next = S.next(ui + 1, nxt);
        const char* nA = has_next ? (const char*)g.A + (size_t)nxt.pm * tstep : cA; const char* nB = has_next ? (const char*)g.Bt + (size_t)nxt.pn * tstep : cB;
        for (int t = 0; t < nt; t += 2) {
            const bool last = (t == nt - 2);
            const char* a1 = cA + (size_t)(t + 1) * kstep;
            const char* a2 = last ? nA : cA + (size_t)(t + 2) * kstep; const char* b2 = last ? nB : cB + (size_t)(t + 2) * kstep;
            const char* a3 = a2 + kstep; const char* b3 = b2 + kstep;
            PG8_LDB(B0, 0, 0); PG8_SCHED; PG8_LDA(At, 0, 0); PG8_STAGE(PG8_SA(1, 1), a1 + hstep, voffA);
            PG8_WAIT_L(8); PG8_BAR; PG8_WAIT_L(0); PG8_MMA(0, 0, At, B0); PG8_BAR; PG8_SCHED;
            PG8_LDB(B1, 0, 1); PG8_STAGE(PG8_SB(0, 0), b2, voffB);
            PG8_BAR; PG8_WAIT_L(0); PG8_MMA(0, 1, At, B1); PG8_BAR;
            PG8_LDA(At, 0, 1); PG8_STAGE(PG8_SA(0, 0), a2, voffA);
            PG8_BAR; PG8_WAIT_L(0); PG8_MMA(1, 0, At, B0); PG8_BAR; PG8_SCHED;
            PG8_STAGE(PG8_SB(0, 1), b2 + hstep, voffB);
            PG8_WAIT_V(6); PG8_BAR; PG8_MMA(1, 1, At, B1); PG8_BAR;
            PG8_LDB(B0, 1, 0); PG8_SCHED; PG8_LDA(At, 1, 0); PG8_STAGE(PG8_SA(0, 1), a2 + hstep, voffA);
            PG8_WAIT_L(8); PG8_BAR; PG8_WAIT_L(0); PG8_MMA(0, 0, At, B0); PG8_BAR; PG8_SCHED;
            PG8_LDB(B1, 1, 1); PG8_STAGE(PG8_SB(1, 0), b3, voffB);
            PG8_BAR; PG8_WAIT_L(0); PG8_MMA(0, 1, At, B1); PG8_BAR;
            PG8_LDA(At, 1, 1); PG8_STAGE(PG8_SA(1, 0), a3, voffA);
            PG8_BAR; PG8_WAIT_L(0); PG8_MMA(1, 0, At, B0); PG8_BAR; PG8_SCHED;
            PG8_STAGE(PG8_SB(1, 1), b3 + hstep, voffB);
            PG8_WAIT_V(6); PG8_BAR; PG8_MMA(1, 1, At, B1); PG8_BAR;
        }
        E(acc, cur, wr, wc, fr, fq);
        if (!has_next) break;
#pragma unroll
        for (int a = 0; a < 2; ++a)
#pragma unroll
            for (int b = 0; b < 2; ++b)
#pragma unroll
                for (int m = 0; m < 4; ++m)
#pragma unroll
                    for (int n = 0; n < 2; ++n) acc[a][b][m][n] = (f32x4){0.f, 0.f, 0.f, 0.f};
        cur = nxt; cA = nA; cB = nB; ++ui;
    }
    PG8_WAIT_V(0);
    if (wr == 0) PG8_BAR;
    PG8_BAR;
#undef PG8_SA
#undef PG8_SB
#undef PG8_STAGE
#undef PG8_LDA
#undef PG8_LDB
#undef PG8_MMA
#undef PG8_WAIT_V
#undef PG8_WAIT_L
#undef PG8_BAR
#undef PG8_SCHED
}
}

struct EpiProj {
    static constexpr bool PERM = true;
    bf16_t* O;
    template <int MODE> __device__ __forceinline__ void run(const f32x4 (&acc)[2][2][4][2], const pg8::Unit& u, int wr, int wc, int fr, int fq) const {
        const int row0 = u.pm * 256 + wr * 64 + fr, col0 = u.pn * 256 + wc * 32 + 8 * fq;
#pragma unroll
        for (int ai = 0; ai < 2; ++ai)
#pragma unroll
            for (int m = 0; m < 4; ++m) { bf16_t* rowp = O + (size_t)(row0 + ai * 128 + m * 16) * LDP + col0;
#pragma unroll
                for (int bj = 0; bj < 2; ++bj) { float f[8];
#pragma unroll
                    for (int q = 0; q < 8; ++q) { const float x = acc[ai][bj][m][q >> 2][q & 3];
                        f[q] = MODE == 0 ? gelu_tanh_f(x) : MODE == 1 ? silu_f(x) : MODE == 2 ? x : sigmoid_f(x); }
                    *(u32x4*)(rowp + bj * 128) = pack8(f); } }
    }
    __device__ __forceinline__ void operator()(const f32x4 (&acc)[2][2][4][2], const pg8::Unit& u, int wr, int wc, int fr, int fq) const {
        const int pn = u.pn;
        if (pn < 8) run<0>(acc, u, wr, wc, fr, fq);
        else if (pn < 12) run<1>(acc, u, wr, wc, fr, fq);
        else if (pn < 37) run<2>(acc, u, wr, wc, fr, fq);
        else if (pn < 45) run<1>(acc, u, wr, wc, fr, fq);
        else run<3>(acc, u, wr, wc, fr, fq);
    }
};
template <bool ADD> struct EpiMerge {
    static constexpr bool PERM = true;
    bf16_t* O; const bf16_t* G;
    __device__ __forceinline__ void operator()(const f32x4 (&acc)[2][2][4][2], const pg8::Unit& u, int wr, int wc, int fr, int fq) const {
        const int row0 = u.pm * 256 + wr * 64 + fr, col0 = u.pn * 256 + wc * 32 + 8 * fq;
#pragma unroll
        for (int ai = 0; ai < 2; ++ai)
#pragma unroll
            for (int m = 0; m < 4; ++m) { const size_t r = (size_t)(row0 + ai * 128 + m * 16);
#pragma unroll
                for (int bj = 0; bj < 2; ++bj) { const int c = col0 + bj * 128; float gt[8], f[8];
                    unpack8(*(const u32x4*)(G + r * LDP + c), gt);
                    if (ADD) unpack8(*(const u32x4*)(O + r * D + c), f);
#pragma unroll
                    for (int q = 0; q < 8; ++q) { const float x = acc[ai][bj][m][q >> 2][q & 3] * gt[q]; f[q] = ADD ? f[q] + x : x; }
                    *(u32x4*)(O + r * D + c) = pack8(f); } }
    }
};
struct EpiOut {
    static constexpr bool PERM = true;
    bf16_t* O; const float* xp; const float* xs; const float* mod;
    __device__ __forceinline__ void operator()(const f32x4 (&acc)[2][2][4][2], const pg8::Unit& u, int wr, int wc, int fr, int fq) const {
        const int row0 = u.pm * 256 + wr * 64 + fr, col0 = u.pn * 256 + wc * 32 + 8 * fq;
#pragma unroll
        for (int ai = 0; ai < 2; ++ai)
#pragma unroll
            for (int m = 0; m < 4; ++m) { const int r = row0 + ai * 128 + m * 16;
                if (r < NTOK) { const float* x = r < NTOK_P ? xp + (size_t)r * D : xs + (size_t)(r - NTOK_P) * D; const int b = r < NTOK_P ? (r >> 11) : 4 + (r - NTOK_P);
                    const float* gate = mod + (size_t)b * 6144 + 4096;
#pragma unroll
                    for (int bj = 0; bj < 2; ++bj) { const int c = col0 + bj * 128; float f[8];
                        const f32x4 x0 = *(const f32x4*)(x + c), x1 = *(const f32x4*)(x + c + 4), g0 = *(const f32x4*)(gate + c), g1 = *(const f32x4*)(gate + c + 4);
                        const f32x4 o0 = x0 + g0 * acc[ai][bj][m][0], o1 = x1 + g1 * acc[ai][bj][m][1];
                        f[0] = o0[0]; f[1] = o0[1]; f[2] = o0[2]; f[3] = o0[3]; f[4] = o1[0]; f[5] = o1[1]; f[6] = o1[2]; f[7] = o1[3];
                        *(u32x4*)(O + (size_t)r * D + c) = pack8(f); } } }
    }
};

typedef float f32x16 __attribute__((ext_vector_type(16)));
template <class Epi> __device__ __forceinline__ void small_gemm(const bf16_t* __restrict__ A, const bf16_t* __restrict__ Bt, int K, LAS float* red, const Epi& epi) {
    const int tid = tid_opaque(), wid = tid >> 6, lane = tid & 63, l31 = lane & 31, lh = lane >> 5;
    for (int tile = blockIdx.x; tile < 256; tile += gridDim.x) {
        const int r0 = (tile & 3) * 32, n0 = (tile >> 2) * 32, kw = wid * (K >> 3), ns = K >> 7;
        const bf16_t* ap = A + (size_t)(r0 + l31) * K + kw + lh * 8; const bf16_t* bp = Bt + (size_t)(n0 + l31) * K + kw + lh * 8;
        f32x16 acc;
#pragma unroll
        for (int v = 0; v < 16; ++v) acc[v] = 0.f;
#pragma unroll 8
        for (int st = 0; st < ns; ++st) { const bf16x8 af = *(const bf16x8*)(ap + st * 16), bf = *(const bf16x8*)(bp + st * 16);
            acc = __builtin_amdgcn_mfma_f32_32x32x16_bf16(bf, af, acc, 0, 0, 0); }
#pragma unroll
        for (int v = 0; v < 16; ++v) red[(wid * 16 + v) * 64 + lane] = acc[v];
        __syncthreads();
        if (tid < 256) { const int g = tid >> 6; f32x4 sum = (f32x4){0.f, 0.f, 0.f, 0.f};
#pragma unroll
            for (int w = 0; w < 8; ++w)
#pragma unroll
                for (int j = 0; j < 4; ++j) sum[j] += red[(w * 16 + g * 4 + j) * 64 + lane];
            epi(sum, r0 + l31, n0 + 8 * g + 4 * lh); }
        __syncthreads();
    }
}

__device__ void mod_tile(PP p, int tile, LAS float* red) {
    const int tid = tid_opaque(), wid = tid >> 6, lane = tid & 63, fr = lane & 15, fq = lane >> 4, n0 = tile * 32;
    const float* wc = p->in[I_WC];
    f32x4 acc[9][2];
#pragma unroll
    for (int a = 0; a < 9; ++a) { acc[a][0] = (f32x4){0.f, 0.f, 0.f, 0.f}; acc[a][1] = (f32x4){0.f, 0.f, 0.f, 0.f}; }
    float bw[2][8], bn[2][8];
#pragma unroll
    for (int nt = 0; nt < 2; ++nt)
#pragma unroll
        for (int j = 0; j < 8; ++j) bw[nt][j] = wc[(size_t)(wid * 256 + fq * 8 + j) * 6144 + n0 + nt * 16 + fr];
#pragma unroll 1
    for (int ks = 0; ks < 8; ++ks) { const int k0 = wid * 256 + ks * 32 + fq * 8;
        if (ks + 1 < 8) {
#pragma unroll
            for (int nt = 0; nt < 2; ++nt)
#pragma unroll
                for (int j = 0; j < 8; ++j) bn[nt][j] = wc[(size_t)(k0 + 32 + j) * 6144 + n0 + nt * 16 + fr]; }
        f32x4 av[9][2];
#pragma unroll
        for (int mt = 0; mt < 9; ++mt) { const int r = mt * 16 + fr;
            if (r < NMODROW) { const float* cp = (r < 4 ? p->in[I_CP] + (size_t)r * D : p->in[I_CS] + (size_t)(r - 4) * D) + k0; av[mt][0] = *(const f32x4*)cp; av[mt][1] = *(const f32x4*)(cp + 4); }
            else { av[mt][0] = (f32x4){0.f, 0.f, 0.f, 0.f}; av[mt][1] = av[mt][0]; } }
        bf16x8 bfr[2];
#pragma unroll
        for (int nt = 0; nt < 2; ++nt) { const u32x4 pk = pack8(bw[nt]); bfr[nt] = __builtin_bit_cast(bf16x8, pk); }
#pragma unroll
        for (int mt = 0; mt < 9; ++mt) { u32x4 pk; pk[0] = cvt_pk_bf16(av[mt][0][0], av[mt][0][1]); pk[1] = cvt_pk_bf16(av[mt][0][2], av[mt][0][3]); pk[2] = cvt_pk_bf16(av[mt][1][0], av[mt][1][1]); pk[3] = cvt_pk_bf16(av[mt][1][2], av[mt][1][3]);
            const bf16x8 afr = __builtin_bit_cast(bf16x8, pk);
            acc[mt][0] = __builtin_amdgcn_mfma_f32_16x16x32_bf16(afr, bfr[0], acc[mt][0], 0, 0, 0);
            acc[mt][1] = __builtin_amdgcn_mfma_f32_16x16x32_bf16(afr, bfr[1], acc[mt][1], 0, 0, 0); }
#pragma unroll
        for (int nt = 0; nt < 2; ++nt)
#pragma unroll
            for (int j = 0; j < 8; ++j) bw[nt][j] = bn[nt][j];
    }
    if (wid >= 4) {
#pragma unroll
        for (int mt = 0; mt < 9; ++mt)
#pragma unroll
            for (int nt = 0; nt < 2; ++nt)
#pragma unroll
                for (int j = 0; j < 4; ++j) red[(wid - 4) * 4608 + (mt * 16 + fq * 4 + j) * 32 + nt * 16 + fr] = acc[mt][nt][j]; }
    __syncthreads();
    if (wid < 4) {
#pragma unroll
        for (int mt = 0; mt < 9; ++mt)
#pragma unroll
            for (int nt = 0; nt < 2; ++nt)
#pragma unroll
                for (int j = 0; j < 4; ++j) red[wid * 4608 + (mt * 16 + fq * 4 + j) * 32 + nt * 16 + fr] += acc[mt][nt][j]; }
    __syncthreads();
    float* mod = (float*)(p->ws + WS_MOD); const float* bc = p->in[I_BC];
    for (int i = tid; i < NMODROW * 32; i += 512) { const int r = i >> 5, c = i & 31; mod[(size_t)r * 6144 + n0 + c] = ((red[i] + red[4608 + i]) + (red[9216 + i] + red[13824 + i])) + bc[n0 + c]; }
    __syncthreads();
}
constexpr int T0_MOD = 192, T0_WIN = 8 * 243, T0_PA = 4 * 32, T0_PB = 8 * 32, T0_WOUT = 8 * 32, NCONV_ALL = T0_WIN + T0_PA + T0_PB + T0_WOUT;
__device__ __forceinline__ void conv_desc(PP p, int u, const float*& sp, int& Nsrc, bf16_t*& dp, int& K) {
    if (u < T0_WIN) { const int tn = u >> 3, tk = u & 7; Nsrc = IN_W; K = D; sp = p->in[I_WIN] + (size_t)tk * 256 * IN_W + tn * 64; dp = (bf16_t*)(p->ws + WS_WTIN) + (size_t)(tn * 64 + (tn >= 147 ? 64 : 0)) * D + tk * 256; return; }
    u -= T0_WIN; Nsrc = D;
    if (u < T0_PA) { const int tk = u & 3, tn = u >> 2; K = A_W; sp = p->in[I_PA] + (size_t)tk * 256 * D + tn * 64; dp = (bf16_t*)(p->ws + WS_WTPA) + (size_t)tn * 64 * A_W + tk * 256; return; }
    u -= T0_PA; K = D; const int tk = u & 7, tn = (u >> 3) & 31;
    if (u < T0_PB) { sp = p->in[I_PB] + (size_t)tk * 256 * D + tn * 64; dp = (bf16_t*)(p->ws + WS_WTPB) + (size_t)tn * 64 * D + tk * 256; return; }
    { sp = p->in[I_WOUT] + (size_t)tk * 256 * D + tn * 64; dp = (bf16_t*)(p->ws + WS_WTOUT) + (size_t)tn * 64 * D + tk * 256; }
}
__device__ void phase0(PP p, LAS unsigned char* lds) {
    const int tid = tid_opaque();
    REP(13) for (int t = blockIdx.x; t < T0_MOD; t += gridDim.x) mod_tile(p, t, (LAS float*)lds);
    const int rb = gridDim.x - 1 - blockIdx.x;
    if (rb == 0) { u32x4* z = (u32x4*)(p->ws + WS_WTIN + (size_t)9408 * D * 2); for (int i = tid; i < 64 * D * 2 / 16; i += 512) z[i] = (u32x4){0u, 0u, 0u, 0u}; }
    for (int it = blockIdx.x; it < 256; it += gridDim.x) { const int w = it >> 7, n0 = (it & 127) * 16; const float* src = p->in[w ? I_A2 : I_W2]; bf16_t* dst = (bf16_t*)(p->ws + (w ? WS_A2T : WS_W2T));
#pragma unroll
        for (int j = 0; j < 3; ++j) { const int i = tid + j * 512, nl = i / 96, k = i % 96; dst[(size_t)(n0 + nl) * 96 + k] = f2bf(src[(size_t)k * B_W + n0 + nl]); } }
    LAS float* t = (LAS float*)lds; volatile LAS int* slot = (volatile LAS int*)(lds + 256 * 65 * 4);
    unsigned* q = (unsigned*)(p->ws + WS_BAR) + 64;
    __syncthreads();
    if (tid == 0) slot[0] = (int)atomicAdd(q, 2u);
    __syncthreads();
    const int NCONV = (gridDim.x == 256) ? T0_WIN : NCONV_ALL;
    int cur = slot[0], nxt = cur + 1;
    f32x4 rg[8], rn[8];
    auto load = [&](int u, f32x4 (&r)[8]) { const float* sp; int Nsrc, K; bf16_t* dp; conv_desc(p, u, sp, Nsrc, dp, K);
#pragma unroll
        for (int i = 0; i < 8; ++i) { const int idx = tid + i * 512; r[i] = *(const f32x4*)(sp + (size_t)(idx >> 4) * Nsrc + (idx & 15) * 4); } };
    if (cur < NCONV) load(cur, rg);
    while (cur < NCONV) {
        int claimed = 0;
        if (tid == 0) claimed = (int)atomicAdd(q, 1u);
        if (nxt < NCONV) load(nxt, rn);
        __syncthreads();
        if (tid == 0) slot[0] = claimed;
#pragma unroll
        for (int i = 0; i < 8; ++i) { const int idx = tid + i * 512, row = idx >> 4, cb = (idx & 15) * 4, hx = (row >> 5) & 7;
            t[row * 65 + (cb ^ hx)] = rg[i][0]; t[row * 65 + ((cb + 1) ^ hx)] = rg[i][1]; t[row * 65 + ((cb + 2) ^ hx)] = rg[i][2]; t[row * 65 + ((cb + 3) ^ hx)] = rg[i][3]; }
        __syncthreads();
        const int n2 = slot[0];
        { const float* sp; int Nsrc, K; bf16_t* dp; conv_desc(p, cur, sp, Nsrc, dp, K);
#pragma unroll
            for (int i = 0; i < 4; ++i) { const int ch = tid + i * 512, nl = ch >> 5, kc = ch & 31; float f[8];
#pragma unroll
                for (int j = 0; j < 8; ++j) f[j] = t[(kc * 8 + j) * 65 + (nl ^ ((kc >> 2) & 7))];
                *(u32x4*)(dp + (size_t)nl * K + kc * 8) = pack8(f); } }
        cur = nxt; nxt = n2;
#pragma unroll
        for (int i = 0; i < 8; ++i) rg[i] = rn[i];
    }
    __syncthreads();
}

__device__ void phase1(PP p) {
    const int tid = tid_opaque(), lane = tid & 63, gw = blockIdx.x * 8 + (tid >> 6), nw = gridDim.x * 8;
    bf16_t* H = (bf16_t*)(p->ws + WS_H); const float* mod = (const float*)(p->ws + WS_MOD); const float* ng = p->in[I_NORMG];
    f32x4 g[8];
#pragma unroll
    for (int i = 0; i < 8; ++i) g[i] = *(const f32x4*)(ng + (lane + 64 * i) * 4);
    auto xrow = [&](int r) { return r < NTOK_P ? p->in[I_XP] + (size_t)r * D : p->in[I_XS] + (size_t)(r - NTOK_P) * D; };
    f32x4 v[8], vn[8];
    if (gw < NTOK) {
#pragma unroll
        for (int i = 0; i < 8; ++i) v[i] = *(const f32x4*)(xrow(gw) + (lane + 64 * i) * 4); }
    for (int r = gw; r < MP; r += nw) {
        bf16_t* hrow = H + (size_t)r * D;
        if (r >= NTOK) { for (int i = 0; i < 4; ++i) *(u32x4*)(hrow + (lane + 64 * i) * 8) = (u32x4){0u, 0u, 0u, 0u}; continue; }
        const int rn = r + nw;
        if (rn < NTOK) {
#pragma unroll
            for (int i = 0; i < 8; ++i) vn[i] = *(const f32x4*)(xrow(rn) + (lane + 64 * i) * 4); }
        const int b = r < NTOK_P ? (r >> 11) : 4 + (r - NTOK_P);
        const float* mrow = mod + (size_t)b * 6144;
        float ss = 0.f;
#pragma unroll
        for (int i = 0; i < 8; ++i) ss += v[i][0] * v[i][0] + v[i][1] * v[i][1] + v[i][2] * v[i][2] + v[i][3] * v[i][3];
        ss = wave_sum(ss); const float rstd = rsqrtf(ss * (1.f / D) + 1e-6f);
#pragma unroll
        for (int i = 0; i < 8; ++i) { const int c = (lane + 64 * i) * 4; const f32x4 sh = *(const f32x4*)(mrow + c), sc = *(const f32x4*)(mrow + 2048 + c);
            const f32x4 h = v[i] * rstd * g[i] * (sc + 1.f) + sh; u32x2 o; o[0] = cvt_pk_bf16(h[0], h[1]); o[1] = cvt_pk_bf16(h[2], h[3]); *(u32x2*)(hrow + c) = o; }
#pragma unroll
        for (int i = 0; i < 8; ++i) v[i] = vn[i];
    }
}

__device__ void mixa_tile(PP p, int tile, LAS unsigned char* lds) {
    const int tid = tid_opaque(), wid = tid >> 6, lane = tid & 63, fr = lane & 15, fq = lane >> 4;
    const int b = tile >> 7, nck = (tile >> 3) & 15, g = tile & 7, row0 = b * SEQ + nck * 128;
    const bf16_t* PROJ = (const bf16_t*)(p->ws + WS_PROJ); bf16_t* YA = (bf16_t*)(p->ws + WS_YA);
    LAS float* mu = (LAS float*)lds; LAS float* rs = mu + 128;
    LAS bf16_t* wA = (LAS bf16_t*)(lds + 1024); LAS bf16_t* vT = wA + 128 * 136;
#pragma unroll
    for (int hb = 0; hb < 2; ++hb) { u32x4 ra[8], rc[8];
#pragma unroll
        for (int k = 0; k < 8; ++k) { const bf16_t* vr = PROJ + (size_t)(row0 + wid * 16 + hb * 8 + k) * LDP + C_VA; ra[k] = *(const u32x4*)(vr + lane * 8); rc[k] = *(const u32x4*)(vr + 512 + lane * 8); }
#pragma unroll
        for (int k = 0; k < 8; ++k) { float a[8], c[8]; unpack8(ra[k], a); unpack8(rc[k], c); float s = 0.f, s2 = 0.f;
#pragma unroll
            for (int q = 0; q < 8; ++q) { s += a[q] + c[q]; s2 += a[q] * a[q] + c[q] * c[q]; }
            s = wave_sum(s); s2 = wave_sum(s2); const float m = s * (1.f / A_W), var = fmaxf(s2 * (1.f / A_W) - m * m, 0.f);
            if (lane == 0) { const int tl = wid * 16 + hb * 8 + k; mu[tl] = m; rs[tl] = rsqrtf(var + 1e-6f); } } }
    const float* wsrc = p->in[I_WS] + (size_t)g * 128 * 128;
#pragma unroll
    for (int i = 0; i < 8; ++i) { const int idx = tid + i * 512, t = idx >> 5, s4 = (idx & 31) * 4; const f32x4 w = *(const f32x4*)(wsrc + t * 128 + s4);
        u32x2 o; o[0] = cvt_pk_bf16(s4 <= t ? w[0] : 0.f, s4 + 1 <= t ? w[1] : 0.f); o[1] = cvt_pk_bf16(s4 + 2 <= t ? w[2] : 0.f, s4 + 3 <= t ? w[3] : 0.f);
        *(LAS u32x2*)(wA + t * 136 + s4) = o; }
    __syncthreads();
    const float* lng = p->in[I_LNG] + g * 128; const float* lnb = p->in[I_LNB] + g * 128;
    u32x2 uar[8], zar[8];
    { const int rowe = row0 + wid * 16 + fr;
#pragma unroll
      for (int ct = 0; ct < 8; ++ct) { const int c = g * 128 + ct * 16 + fq * 4; uar[ct] = *(const u32x2*)(PROJ + (size_t)rowe * LDP + C_UA + c); zar[ct] = *(const u32x2*)(PROJ + (size_t)rowe * LDP + C_ZA + c); } }
#pragma unroll
    for (int i = 0; i < 4; ++i) { const int idx = tid + i * 512, s = idx >> 4, c8 = (idx & 15) * 8; float x[8];
        unpack8(*(const u32x4*)(PROJ + (size_t)(row0 + s) * LDP + C_VA + g * 128 + c8), x); const float m = mu[s], r = rs[s];
        const f32x4 g0 = *(const f32x4*)(lng + c8), g1 = *(const f32x4*)(lng + c8 + 4), b0 = *(const f32x4*)(lnb + c8), b1 = *(const f32x4*)(lnb + c8 + 4);
        const int ssw = s ^ (((c8 >> 3) & 7) << 3);
#pragma unroll
        for (int q = 0; q < 8; ++q) vT[(c8 + q) * 136 + ssw] = f2bf((x[q] - m) * r * (q < 4 ? g0[q & 3] : g1[q & 3]) + (q < 4 ? b0[q & 3] : b1[q & 3])); }
    __syncthreads();
    const int t0 = wid * 16, nks = (t0 + 15) / 32 + 1;
    bf16x8 af[4];
#pragma unroll
    for (int ks = 0; ks < 4; ++ks) af[ks] = *(const LAS bf16x8*)(wA + (t0 + fr) * 136 + (ks < nks ? ks : 0) * 32 + fq * 8);
    const int row = row0 + t0 + fr; const float bias = p->in[I_BS][g * 128 + t0 + fr];
#pragma unroll
    for (int ct = 0; ct < 8; ++ct) { f32x4 acc = (f32x4){0.f, 0.f, 0.f, 0.f};
#pragma unroll
        for (int ks = 0; ks < 4; ++ks) if (ks < nks) { const int cch = ct * 16 + fr; const bf16x8 bfr = *(const LAS bf16x8*)(vT + cch * 136 + ((ks * 32 + fq * 8) ^ (((cch >> 3) & 7) << 3)));
            acc = __builtin_amdgcn_mfma_f32_16x16x32_bf16(bfr, af[ks], acc, 0, 0, 0); }
        const int c = g * 128 + ct * 16 + fq * 4;
        const u32x2 ua = uar[ct], za = zar[ct];
        u32x2 o; o[0] = cvt_pk_bf16(bflo(ua[0]) * (acc[0] + bias) * bflo(za[0]), bfhi(ua[0]) * (acc[1] + bias) * bfhi(za[0]));
        o[1] = cvt_pk_bf16(bflo(ua[1]) * (acc[2] + bias) * bflo(za[1]), bfhi(ua[1]) * (acc[3] + bias) * bfhi(za[1]));
        *(u32x2*)(YA + (size_t)row * A_W + c) = o; }
    __syncthreads();
}
__device__ void mixa_sample_row(PP p, int bs) {
    const int lane = tid_opaque() & 63, row = NTOK_P + bs;
    const bf16_t* pr = (const bf16_t*)(p->ws + WS_PROJ) + (size_t)row * LDP; bf16_t* YA = (bf16_t*)(p->ws + WS_YA) + (size_t)row * A_W; float* cv = p->out + O_CV + (size_t)bs * A_W;
    float x[2][8]; unpack8(*(const u32x4*)(pr + C_VA + lane * 8), x[0]); unpack8(*(const u32x4*)(pr + C_VA + 512 + lane * 8), x[1]);
    float s = 0.f, s2 = 0.f;
#pragma unroll
    for (int q = 0; q < 8; ++q) { s += x[0][q] + x[1][q]; s2 += x[0][q] * x[0][q] + x[1][q] * x[1][q]; }
    s = wave_sum(s); s2 = wave_sum(s2); const float m = s * (1.f / A_W), r = rsqrtf(fmaxf(s2 * (1.f / A_W) - m * m, 0.f) + 1e-6f);
#pragma unroll
    for (int hlf = 0; hlf < 2; ++hlf) { const int c0 = hlf * 512 + lane * 8, g = c0 >> 7; const float w00 = p->in[I_WS][(size_t)g * 128 * 128], b0 = p->in[I_BS][g * 128];
        float ua[8], za[8], f[8], vn[8]; unpack8(*(const u32x4*)(pr + C_UA + c0), ua); unpack8(*(const u32x4*)(pr + C_ZA + c0), za);
#pragma unroll
        for (int q = 0; q < 8; ++q) { vn[q] = (x[hlf][q] - m) * r * p->in[I_LNG][c0 + q] + p->in[I_LNB][c0 + q]; f[q] = ua[q] * (w00 * vn[q] + b0) * za[q]; }
        *(f32x4*)(cv + c0) = (f32x4){vn[0], vn[1], vn[2], vn[3]}; *(f32x4*)(cv + c0 + 4) = (f32x4){vn[4], vn[5], vn[6], vn[7]};
        *(u32x4*)(YA + c0) = pack8(f); }
}

template <bool SMP> __device__ __forceinline__ void lora_stage(PP p, int T0, int tid, LAS bf16_t* Aw, LAS bf16_t* Aa) {
    const bf16_t* PROJ = (const bf16_t*)(p->ws + WS_PROJ); const float* mu = p->in[I_MU];
#pragma unroll 1
    for (int hb = 0; hb < 2; ++hb) {
        u32x4 cur[4], prv[4]; f32x4 pf0[4], pf1[4];
#pragma unroll
        for (int k = 0; k < 4; ++k) { const int idx = tid + (hb * 4 + k) * 512, which = idx >= 144 * 12, i2 = which ? idx - 144 * 12 : idx, tl = i2 / 12, ch = i2 % 12, row = T0 + tl, off = (which ? PR_AD : PR_WD) + ch * 8;
            const bool act = idx < 144 * 12 * 2 && tl < 130 && (SMP ? row >= NTOK_P : row < NTOK_P);
            const int srow = act ? row : T0;
            const bf16_t* pr = PROJ + (size_t)srow * LDP + C_PR + off; cur[k] = *(const u32x4*)pr;
            if (SMP) { const float* sh = p->in[I_SSH] + (size_t)(act ? row - NTOK_P : 0) * SHIFT_W + off; pf0[k] = *(const f32x4*)sh; pf1[k] = *(const f32x4*)(sh + 4); prv[k] = cur[k]; }
            else { const bool first = !act || (srow & (SEQ - 1)) == 0; prv[k] = *(const u32x4*)(first ? pr : pr - LDP); pf0[k] = (f32x4){0.f, 0.f, 0.f, 0.f}; pf1[k] = pf0[k]; } }
#pragma unroll
        for (int k = 0; k < 4; ++k) { const int idx = tid + (hb * 4 + k) * 512, which = idx >= 144 * 12, i2 = which ? idx - 144 * 12 : idx, tl = i2 / 12, ch = i2 % 12, row = T0 + tl, off = (which ? PR_AD : PR_WD) + ch * 8;
            const bool inr = idx < 144 * 12 * 2, act = inr && tl < 130 && (SMP ? row >= NTOK_P : row < NTOK_P);
            const f32x4 m0 = *(const f32x4*)(mu + off), m1 = *(const f32x4*)(mu + off + 4);
            float c[8], pv[8], f[8]; unpack8(cur[k], c);
            if (SMP) { pv[0] = pf0[k][0]; pv[1] = pf0[k][1]; pv[2] = pf0[k][2]; pv[3] = pf0[k][3]; pv[4] = pf1[k][0]; pv[5] = pf1[k][1]; pv[6] = pf1[k][2]; pv[7] = pf1[k][3]; }
            else { unpack8(prv[k], pv); const float keep = (row & (SEQ - 1)) == 0 ? 0.f : 1.f;
#pragma unroll
                for (int q = 0; q < 8; ++q) pv[q] *= keep; }
#pragma unroll
            for (int q = 0; q < 8; ++q) { const float x = c[q] + (q < 4 ? m0[q & 3] : m1[q & 3]) * (pv[q] - c[q]); f[q] = which ? x : tanh_fast(x); }
            const u32x4 o = act ? pack8(f) : (u32x4){0u, 0u, 0u, 0u};
            if (SMP ? act : (inr && (tl >= 130 || row < NTOK_P))) *(LAS u32x4*)((which ? Aa : Aw) + tl * 104 + ch * 8) = o; }
    }
}
__device__ void lora_tile(PP p, int tile, LAS unsigned char* lds) {
    const int tid = tid_opaque(), wid = tid >> 6, lane = tid & 63, fr = lane & 15, fq = lane >> 4, cs = tile & 3, T0 = (tile >> 2) * 130;
    const bf16_t* PROJ = (const bf16_t*)(p->ws + WS_PROJ); const float* mu = p->in[I_MU];
    LAS bf16_t* Aw = (LAS bf16_t*)lds; LAS bf16_t* Aa = Aw + 144 * 104;
    bf16x8 bfr[2][4][3]; f32x4 bias[2][4];
#pragma unroll
    for (int lo = 0; lo < 2; ++lo) { const bf16_t* Bt = (const bf16_t*)(p->ws + (lo ? WS_A2T : WS_W2T)); const float* b0 = p->in[lo ? I_A0 : I_W0];
#pragma unroll
        for (int nt = 0; nt < 4; ++nt) { const int n0 = cs * 512 + wid * 64 + nt * 16; bias[lo][nt] = *(const f32x4*)(b0 + n0 + fq * 4);
#pragma unroll
            for (int ks = 0; ks < 3; ++ks) bfr[lo][nt][ks] = *(const bf16x8*)(Bt + (size_t)(n0 + fr) * 96 + ks * 32 + fq * 8); } }
    lora_stage<false>(p, T0, tid, Aw, Aa);
    if (T0 + 130 > NTOK_P) lora_stage<true>(p, T0, tid, Aw, Aa);
    __syncthreads();
#pragma unroll 1
    for (int mt = 0; mt < 9; ++mt) { const int tl = mt * 16 + fr, row = T0 + tl; const bool ok = tl < 130;
#pragma unroll
        for (int lo = 0; lo < 2; ++lo) { const LAS bf16_t* A = lo ? Aa : Aw; bf16x8 af[3];
#pragma unroll
            for (int ks = 0; ks < 3; ++ks) af[ks] = *(const LAS bf16x8*)(A + tl * 104 + ks * 32 + fq * 8);
            bf16_t* op = lo ? (bf16_t*)(p->ws + WS_AAA) + (size_t)row * D : (row >= NTOK_P ? (bf16_t*)(p->ws + WS_ES) + (size_t)(row - NTOK_P) * D : (bf16_t*)(p->ws + WS_E) + (size_t)row * D);
            const float mul = lo ? 1.f : 0.6065306597126334f;
#pragma unroll
            for (int nt = 0; nt < 4; ++nt) { f32x4 acc = (f32x4){0.f, 0.f, 0.f, 0.f};
#pragma unroll
                for (int ks = 0; ks < 3; ++ks) acc = __builtin_amdgcn_mfma_f32_16x16x32_bf16(bfr[lo][nt][ks], af[ks], acc, 0, 0, 0);
                u32x2 o; o[0] = cvt_pk_bf16(sigmoid_f(acc[0] + bias[lo][nt][0]) * mul, sigmoid_f(acc[1] + bias[lo][nt][1]) * mul); o[1] = cvt_pk_bf16(sigmoid_f(acc[2] + bias[lo][nt][2]) * mul, sigmoid_f(acc[3] + bias[lo][nt][3]) * mul);
                if (ok) *(u32x2*)(op + cs * 512 + wid * 64 + nt * 16 + fq * 4) = o; } } }
    __syncthreads();
}
constexpr int T3_MIXA = 512, T3_MIXS = 16, T3_LORA = 256, T3_TOTAL = T3_MIXA + T3_MIXS + T3_LORA;
__device__ void phase3(PP p, LAS unsigned char* lds) {
    REP(11) for (int t = blockIdx.x; t < T3_MIXA + T3_MIXS; t += gridDim.x) {
        if (t < T3_MIXA) mixa_tile(p, t, lds);
        else mixa_sample_row(p, (t - T3_MIXA) * 8 + (tid_opaque() >> 6));
    }
    REP(12) for (int t = blockIdx.x; t < T3_LORA; t += gridDim.x) lora_tile(p, (t + 16) % T3_LORA, lds);
}

struct HeadPar { float mu_r, mu_k, mu_v, kk_s, ka, rk; };
__device__ __forceinline__ float head_vectors(const HeadPar& hp, float r_c, float k_c, float v_c, float r_p, float k_p, float v_p, float a, float e, LAS float* dst, int j, float& v_out) {
    const float r = r_c + hp.mu_r * (r_p - r_c), k = k_c + hp.mu_k * (k_p - k_c), v = v_c + hp.mu_v * (v_p - v_c);
    const float w = __expf(-e);
    float kk = k * hp.kk_s; const float n2 = wave_sum(kk * kk); kk = kk / fmaxf(sqrtf(n2), 1e-12f);
    const float kp = k * (1.f + (a - 1.f) * hp.ka), bb = kk * a;
    const float cc = wave_sum(r * kp * hp.rk);
    dst[j] = r; dst[64 + j] = w; dst[128 + j] = kp; dst[192 + j] = kk; dst[256 + j] = bb; dst[320 + j] = v; v_out = v;
    return cc;
}
struct SmpRegs { f32x4 S[16]; bf16_t r_c, k_c, v_c, e, a, zb; float r_p, k_p, v_p, gng, gnb; HeadPar hp; };
__device__ __forceinline__ void smp_load(PP p, int item, SmpRegs& R, int lane_) {
    int lane = lane_; asm volatile("" : "+v"(lane));
    const int bs = item >> 5, h = item & 31, hc = h * 64 + lane; const size_t row = NTOK_P + bs;
    const bf16_t* PROJ = (const bf16_t*)(p->ws + WS_PROJ);
    const bf16_t* pr = PROJ + row * LDP + C_PR + hc; const float* sh = p->in[I_SSH] + (size_t)bs * SHIFT_W + hc;
    R.r_c = pr[PR_R]; R.k_c = pr[PR_K]; R.v_c = pr[PR_V]; R.r_p = sh[PR_R]; R.k_p = sh[PR_K]; R.v_p = sh[PR_V];
    R.e = ((const bf16_t*)(p->ws + WS_ES))[(size_t)bs * D + hc]; R.a = ((const bf16_t*)(p->ws + WS_AAA))[row * D + hc]; R.zb = PROJ[row * LDP + C_ZB + hc];
    R.hp.mu_r = p->in[I_MU][PR_R + hc]; R.hp.mu_k = p->in[I_MU][PR_K + hc]; R.hp.mu_v = p->in[I_MU][PR_V + hc]; R.hp.kk_s = p->in[I_KK][hc]; R.hp.ka = p->in[I_KA][hc]; R.hp.rk = p->in[I_RK][hc];
    R.gng = p->in[I_GNG][hc]; R.gnb = p->in[I_GNB][hc];
    const float* s0 = p->in[I_SWKV] + ((size_t)(bs * 32 + h) * 64 + lane) * 64;
#pragma unroll
    for (int q = 0; q < 16; ++q) R.S[q] = *(const f32x4*)(s0 + q * 4);
}
__device__ __forceinline__ void smp_finish(PP p, int item, SmpRegs& R, LAS float* wl, int lane_) {
    int lane = lane_; asm volatile("" : "+v"(lane));
    const int bs = item >> 5, h = item & 31, hc = h * 64 + lane; const size_t row = NTOK_P + bs;
    float v; const float cc = head_vectors(R.hp, bf2f(R.r_c), bf2f(R.k_c), bf2f(R.v_c), R.r_p, R.k_p, R.v_p, bf2f(R.a), bf2f(R.e), wl, lane, v);
    __builtin_amdgcn_wave_barrier();
    float* s1 = p->out + O_WKVS + ((size_t)(bs * 32 + h) * 64 + lane) * 64;
    float sp = 0.f;
#pragma unroll
    for (int q = 0; q < 16; ++q) { const f32x4 kk = *(const LAS f32x4*)(wl + 192 + q * 4); sp += R.S[q][0] * kk[0] + R.S[q][1] * kk[1] + R.S[q][2] * kk[2] + R.S[q][3] * kk[3]; if ((q & 3) == 3) __builtin_amdgcn_sched_barrier(0); }
    const float sa = -sp; float y = 0.f;
#pragma unroll
    for (int q = 0; q < 16; ++q) { const f32x4 w = *(const LAS f32x4*)(wl + 64 + q * 4), bb = *(const LAS f32x4*)(wl + 256 + q * 4), kp = *(const LAS f32x4*)(wl + 128 + q * 4), r = *(const LAS f32x4*)(wl + q * 4);
        const f32x4 sn = R.S[q] * w + sa * bb + v * kp; y += sn[0] * r[0] + sn[1] * r[1] + sn[2] * r[2] + sn[3] * r[3]; *(f32x4*)(s1 + q * 4) = sn; if ((q & 1) == 1) __builtin_amdgcn_sched_barrier(0); }
    const float m = wave_sum(y) * (1.f / 64.f), d = y - m, var = wave_sum(d * d) * (1.f / 64.f);
    const float yn = d * rsqrtf(var + 64e-5f) * R.gng + R.gnb;
    ((bf16_t*)(p->ws + WS_YB))[row * D + hc] = f2bf((yn + cc * v) * bf2f(R.zb));
    __builtin_amdgcn_wave_barrier();
}
__device__ void scan_sample_item(PP p, int item, LAS float* wl) {
    const int lane = tid_opaque() & 63; SmpRegs R; smp_load(p, item, R, lane); smp_finish(p, item, R, wl, lane);
}
constexpr int BGC_PA = 32 * 32, BGC_PB = 64 * 32, BGC_WO = 64 * 32, BGC_TOTAL = BGC_PA + BGC_PB + BGC_WO, BGC_WAVES = 768;
struct BgcRegs { f32x4 r[8]; };
__device__ __forceinline__ void bgc_desc(PP p, int u, const float*& sp, bf16_t*& dp, int& K) {
    if (u < BGC_PA) { const int tk = u & 31, tn = u >> 5; K = A_W; sp = p->in[I_PA] + (size_t)tk * 32 * D + tn * 64; dp = (bf16_t*)(p->ws + WS_WTPA) + (size_t)tn * 64 * A_W + tk * 32; return; }
    u -= BGC_PA; K = D; const int tk = u & 63, tn = (u >> 6) & 31;
    if (u < BGC_PB) { sp = p->in[I_PB] + (size_t)tk * 32 * D + tn * 64; dp = (bf16_t*)(p->ws + WS_WTPB) + (size_t)tn * 64 * D + tk * 32; return; }
    sp = p->in[I_WOUT] + (size_t)tk * 32 * D + tn * 64; dp = (bf16_t*)(p->ws + WS_WTOUT) + (size_t)tn * 64 * D + tk * 32;
}
__device__ __forceinline__ void bgc_load(PP p, int u, BgcRegs& R, int lane_) {
    int lane = lane_; asm volatile("" : "+v"(lane));
    const float* sp; bf16_t* dp; int K; bgc_desc(p, u, sp, dp, K);
#pragma unroll
    for (int i = 0; i < 8; ++i) { const int idx = lane + 64 * i; R.r[i] = *(const f32x4*)(sp + (size_t)(idx >> 4) * D + (idx & 15) * 4); }
}
__device__ __forceinline__ void bgc_finish(PP p, int u, const BgcRegs& R, LAS float* t, int lane_) {
    int lane = lane_; asm volatile("" : "+v"(lane));
    const float* sp; bf16_t* dp; int K; bgc_desc(p, u, sp, dp, K);
#pragma unroll
    for (int i = 0; i < 8; ++i) { const int idx = lane + 64 * i, o = (idx >> 4) * 65 + (idx & 15) * 4; t[o] = R.r[i][0]; t[o + 1] = R.r[i][1]; t[o + 2] = R.r[i][2]; t[o + 3] = R.r[i][3]; }
    __builtin_amdgcn_wave_barrier();
#pragma unroll
    for (int i = 0; i < 4; ++i) { const int ch = lane + 64 * i, nl = ch >> 2, kc = ch & 3; float f[8];
#pragma unroll
        for (int j = 0; j < 8; ++j) f[j] = t[(kc * 8 + j) * 65 + nl];
        *(u32x4*)(dp + (size_t)nl * K + kc * 8) = pack8(f); }
    __builtin_amdgcn_wave_barrier();
}
constexpr int TS = 32, CHF = TS * 384, NCH = SEQ / TS;
__device__ __forceinline__ float red16(float x) { x += dppf<0xB1>(x); x += dppf<0x4E>(x); x += dppf<0x141>(x); x += dppf<0x140>(x); return x; }
struct LdRegs { u32x4 rc, kc, vc, rp, kp, vp, e, a; };
struct StepRegs { f32x4 r, w, k, q, b; f32x2 v;
    __device__ __forceinline__ void ld(const LAS float* L, int cq, int i0) { r = *(const LAS f32x4*)(L + cq); w = *(const LAS f32x4*)(L + 64 + cq); k = *(const LAS f32x4*)(L + 128 + cq); q = *(const LAS f32x4*)(L + 192 + cq); b = *(const LAS f32x4*)(L + 256 + cq); v = *(const LAS f32x2*)(L + 320 + i0); } };
__device__ void scan_prompt_item(PP p, int item, LAS float* lds) {
    const int tid = tid_opaque(), wid = __builtin_amdgcn_readfirstlane(tid >> 6), lane = tid & 63;
    const int b = item >> 6, h = (item >> 1) & 31, half = item & 1;
    const bf16_t* PROJ = (const bf16_t*)(p->ws + WS_PROJ);
    if (wid >= 4) {
        const int lw = wid - 4, sl = lw * 8 + (lane >> 3), ch0 = (lane & 7) * 8, hc_ = h * 64 + ch0;
        const bf16_t* E = (const bf16_t*)(p->ws + WS_E); const bf16_t* AAA = (const bf16_t*)(p->ws + WS_AAA); float* Cc = (float*)(p->ws + WS_C);
        const bool wr_c = (half == 0) && ((lane & 7) == 0);
        auto load = [&](int c, LdRegs& R) { int hc = hc_; asm volatile("" : "+v"(hc)); const int t = c * TS + sl; const size_t row = (size_t)b * SEQ + t; const bf16_t* pr = PROJ + row * LDP + C_PR + hc;
            R.rc = *(const u32x4*)(pr + PR_R); R.kc = *(const u32x4*)(pr + PR_K); R.vc = *(const u32x4*)(pr + PR_V);
            if (t > 0) { R.rp = *(const u32x4*)(pr + PR_R - LDP); R.kp = *(const u32x4*)(pr + PR_K - LDP); R.vp = *(const u32x4*)(pr + PR_V - LDP); }
            else { R.rp = (u32x4){0u, 0u, 0u, 0u}; R.kp = R.rp; R.vp = R.rp; }
            R.e = *(const u32x4*)(E + row * D + hc); R.a = *(const u32x4*)(AAA + row * D + hc); };
        auto process = [&](int c, const LdRegs& R) { int hc = hc_; asm volatile("" : "+v"(hc)); LAS float* dst = lds + (c & 1) * CHF + sl * 384 + ch0;
            float rc[8], kc[8], vc[8], rp[8], kp[8], vp[8], e[8], a[8], r[8], k[8], v[8], w[8], kk[8], kq[8], bb[8];
            float mu_r[8], mu_k[8], mu_v[8], kks[8], ka[8], rk[8];
            { const float* mb = p->in[I_MU] + hc; const f32x4 a0 = *(const f32x4*)(mb + PR_R), a1 = *(const f32x4*)(mb + PR_R + 4), b0 = *(const f32x4*)(mb + PR_K), b1 = *(const f32x4*)(mb + PR_K + 4), c0 = *(const f32x4*)(mb + PR_V), c1 = *(const f32x4*)(mb + PR_V + 4);
              const f32x4 d0 = *(const f32x4*)(p->in[I_KK] + hc), d1 = *(const f32x4*)(p->in[I_KK] + hc + 4), e0 = *(const f32x4*)(p->in[I_KA] + hc), e1 = *(const f32x4*)(p->in[I_KA] + hc + 4), f0 = *(const f32x4*)(p->in[I_RK] + hc), f1 = *(const f32x4*)(p->in[I_RK] + hc + 4);
#pragma unroll
              for (int q = 0; q < 4; ++q) { mu_r[q] = a0[q]; mu_r[4 + q] = a1[q]; mu_k[q] = b0[q]; mu_k[4 + q] = b1[q]; mu_v[q] = c0[q]; mu_v[4 + q] = c1[q]; kks[q] = d0[q]; kks[4 + q] = d1[q]; ka[q] = e0[q]; ka[4 + q] = e1[q]; rk[q] = f0[q]; rk[4 + q] = f1[q]; } }
            unpack8(R.rc, rc); unpack8(R.kc, kc); unpack8(R.vc, vc); unpack8(R.rp, rp); unpack8(R.kp, kp); unpack8(R.vp, vp); unpack8(R.e, e); unpack8(R.a, a);
            float n2 = 0.f, cc = 0.f;
#pragma unroll
            for (int q = 0; q < 8; ++q) { r[q] = rc[q] + mu_r[q] * (rp[q] - rc[q]); k[q] = kc[q] + mu_k[q] * (kp[q] - kc[q]); v[q] = vc[q] + mu_v[q] * (vp[q] - vc[q]);
                w[q] = __builtin_amdgcn_exp2f(-1.4426950408889634f * e[q]); kk[q] = k[q] * kks[q]; n2 += kk[q] * kk[q];
                kq[q] = k[q] * (1.f + (a[q] - 1.f) * ka[q]); cc += r[q] * kq[q] * rk[q]; }
            n2 = red8(n2); cc = red8(cc); const float inv = 1.f / fmaxf(sqrtf(n2), 1e-12f);
#pragma unroll
            for (int q = 0; q < 8; ++q) { kk[q] *= inv; bb[q] = kk[q] * a[q]; }
            *(LAS f32x4*)(dst) = (f32x4){r[0], r[1], r[2], r[3]}; *(LAS f32x4*)(dst + 4) = (f32x4){r[4], r[5], r[6], r[7]};
            *(LAS f32x4*)(dst + 64) = (f32x4){w[0], w[1], w[2], w[3]}; *(LAS f32x4*)(dst + 68) = (f32x4){w[4], w[5], w[6], w[7]};
            *(LAS f32x4*)(dst + 128) = (f32x4){kq[0], kq[1], kq[2], kq[3]}; *(LAS f32x4*)(dst + 132) = (f32x4){kq[4], kq[5], kq[6], kq[7]};
            *(LAS f32x4*)(dst + 192) = (f32x4){kk[0], kk[1], kk[2], kk[3]}; *(LAS f32x4*)(dst + 196) = (f32x4){kk[4], kk[5], kk[6], kk[7]};
            *(LAS f32x4*)(dst + 256) = (f32x4){bb[0], bb[1], bb[2], bb[3]}; *(LAS f32x4*)(dst + 260) = (f32x4){bb[4], bb[5], bb[6], bb[7]};
            *(LAS f32x4*)(dst + 320) = (f32x4){v[0], v[1], v[2], v[3]}; *(LAS f32x4*)(dst + 324) = (f32x4){v[4], v[5], v[6], v[7]};
            if (wr_c) Cc[((size_t)b * SEQ + c * TS + sl) * 32 + h] = cc; };
        const bool bg = (gridDim.x == 256); const int gidx = blockIdx.x * 4 + lw; LAS float* wl = lds + 2 * CHF + lw * 384;
        auto chunk_head = [&]() { asm volatile("s_waitcnt lgkmcnt(0)" ::: "memory");
            __builtin_amdgcn_s_barrier(); asm volatile("" ::: "memory"); };
        LdRegs R; load(0, R); process(0, R); load(1, R);
        auto chunk_tail = [&](int c) { if (c + 1 < NCH) { process(c + 1, R); if (c + 2 < NCH) load(c + 2, R); } };
        LAS float* tl = lds + 2 * CHF + 4 * 384 + (lw < 3 ? lw : 0) * (32 * 65);
        const int gw3 = blockIdx.x * 3 + lw;
        auto plain = [&](int ca, int cb) {
#pragma unroll 1
            for (int c = ca; c < cb; ++c) { chunk_head(); chunk_tail(c); } };
        auto conv_slot = [&](int c, int k) { const int u = gw3 + BGC_WAVES * k;
            if (bg && lw < 3 && u < BGC_TOTAL) { BgcRegs CR; bgc_load(p, u, CR, lane); chunk_head(); bgc_finish(p, u, CR, tl, lane); chunk_tail(c); }
            else { chunk_head(); chunk_tail(c); } };
#pragma unroll 1
        for (int seg = 0; seg < NCH / 16; ++seg) { const int c0 = seg * 16;
            plain(c0, c0 + 3);
            if (bg) { SmpRegs SR; const int item = gidx + 1024 * seg; smp_load(p, item, SR, lane); chunk_head(); smp_finish(p, item, SR, wl, lane); chunk_tail(c0 + 3); }
            else { chunk_head(); chunk_tail(c0 + 3); }
            plain(c0 + 4, c0 + 7);
            conv_slot(c0 + 7, seg * 2);
            plain(c0 + 8, c0 + 12);
            conv_slot(c0 + 12, seg * 2 + 1);
            plain(c0 + 13, c0 + 16);
        }
    } else {
        __builtin_amdgcn_s_setprio(3);
        const int rp = lane >> 4, cq = (lane & 15) * 4, i0 = half * 32 + wid * 8 + rp * 2;
        bf16_t* Y = (bf16_t*)(p->ws + WS_Y) + (size_t)b * SEQ * D + h * 64 + i0;
        f32x2 S0a = {0.f, 0.f}, S0b = {0.f, 0.f}, S1a = {0.f, 0.f}, S1b = {0.f, 0.f};
        const int lq = lane & 15;
        for (int c = 0; c < NCH; ++c) {
            __syncthreads();
            const LAS float* L = lds + (c & 1) * CHF;
            StepRegs nx; nx.ld(L, cq, i0);
#pragma unroll
            for (int g = 0; g < TS / 16; ++g) {
                float yk = 0.f;
#pragma unroll
                for (int s = 0; s < 16; ++s) {
                    const StepRegs cu = nx; L += 384;
                    if (s < 15 || g + 1 < TS / 16) nx.ld(L, cq, i0);
                    __builtin_amdgcn_sched_barrier(0x477);
                    const f32x4 r4 = cu.r, w4 = cu.w, k4 = cu.k, q4 = cu.q, b4 = cu.b; const f32x2 v2 = cu.v;
                    const f32x2 ra = {r4[0], r4[1]}, rb = {r4[2], r4[3]}, wa = {w4[0], w4[1]}, wb = {w4[2], w4[3]}, ka_ = {k4[0], k4[1]}, kb = {k4[2], k4[3]}, qa = {q4[0], q4[1]}, qb = {q4[2], q4[3]}, ba = {b4[0], b4[1]}, bb_ = {b4[2], b4[3]};
                    f32x2 t0 = __builtin_elementwise_fma(S0b, qb, S0a * qa), t1 = __builtin_elementwise_fma(S1b, qb, S1a * qa);
                    const float sa0 = -red16(t0[0] + t0[1]), sa1 = -red16(t1[0] + t1[1]);
                    const f32x2 sa0v = {sa0, sa0}, sa1v = {sa1, sa1}, v0v = {v2[0], v2[0]}, v1v = {v2[1], v2[1]};
                    S0a = __builtin_elementwise_fma(S0a, wa, __builtin_elementwise_fma(sa0v, ba, v0v * ka_)); S0b = __builtin_elementwise_fma(S0b, wb, __builtin_elementwise_fma(sa0v, bb_, v0v * kb));
                    S1a = __builtin_elementwise_fma(S1a, wa, __builtin_elementwise_fma(sa1v, ba, v1v * ka_)); S1b = __builtin_elementwise_fma(S1b, wb, __builtin_elementwise_fma(sa1v, bb_, v1v * kb));
                    t0 = __builtin_elementwise_fma(S0b, rb, S0a * ra); t1 = __builtin_elementwise_fma(S1b, rb, S1a * ra);
                    const float x0 = t0[0] + t0[1], x1 = t1[0] + t1[1];
                    const bool odd = lane & 1; float u = odd ? x1 : x0; const float vv = odd ? x0 : x1;
                    u += dppf<0xB1>(vv); u += dppf<0x4E>(u); u += dppf<0x124>(u); u += dppf<0x128>(u);
                    yk = ((lq >> 1) == (s & 7)) ? u : yk;
                    if ((s & 7) == 7) Y[(size_t)(c * TS + g * 16 + (s - 7) + (lq >> 1)) * D + (lq & 1)] = f2bf(yk);
                }
            }
        }
        __builtin_amdgcn_s_setprio(0);
        float* so = p->out + O_WKVP + ((size_t)(b * 32 + h) * 64 + i0) * 64 + cq;
        *(f32x4*)so = (f32x4){S0a[0], S0a[1], S0b[0], S0b[1]}; *(f32x4*)(so + 64) = (f32x4){S1a[0], S1a[1], S1b[0], S1b[1]};
    }
    __syncthreads();
}
__device__ void phase4(PP p, LAS unsigned char* lds) {
    REP(4) for (int it = blockIdx.x; it < 256; it += gridDim.x) scan_prompt_item(p, it, (LAS float*)lds);
    const int wid = __builtin_amdgcn_readfirstlane(tid_opaque() >> 6);
    if (gridDim.x != 256) for (int it = blockIdx.x * 8 + wid; it < 4096; it += gridDim.x * 8) scan_sample_item(p, it, (LAS float*)lds + wid * 384);
}

__device__ void phase5(PP p) {
    const int tid = tid_opaque(), lane = tid & 63, gw = blockIdx.x * 8 + (tid >> 6), nw = gridDim.x * 8;
    const bf16_t* PROJ = (const bf16_t*)(p->ws + WS_PROJ); const bf16_t* Y = (const bf16_t*)(p->ws + WS_Y); const float* Cc = (const float*)(p->ws + WS_C); bf16_t* YB = (bf16_t*)(p->ws + WS_YB);
    f32x4 pmu[4][2], pg[4][2], pb[4][2];
#pragma unroll
    for (int q = 0; q < 4; ++q) { const int c0 = q * 512 + lane * 8;
#pragma unroll
        for (int hh = 0; hh < 2; ++hh) { pmu[q][hh] = *(const f32x4*)(p->in[I_MU] + PR_V + c0 + hh * 4); pg[q][hh] = *(const f32x4*)(p->in[I_GNG] + c0 + hh * 4); pb[q][hh] = *(const f32x4*)(p->in[I_GNB] + c0 + hh * 4); } }
    for (int row = gw; row < NTOK_P; row += nw) { const bool first = (row & (SEQ - 1)) == 0; const bf16_t* pr = PROJ + (size_t)row * LDP;
        u32x4 yr[4], vcr[4], vpr[4], zbr[4]; float ccs[4];
#pragma unroll
        for (int q = 0; q < 4; ++q) { const int c0 = q * 512 + lane * 8;
            yr[q] = *(const u32x4*)(Y + (size_t)row * D + c0);
            vcr[q] = *(const u32x4*)(pr + C_PR + PR_V + c0); vpr[q] = first ? (u32x4){0u, 0u, 0u, 0u} : *(const u32x4*)(pr - LDP + C_PR + PR_V + c0);
            zbr[q] = *(const u32x4*)(pr + C_ZB + c0); ccs[q] = Cc[(size_t)row * 32 + (c0 >> 6)]; }
#pragma unroll
        for (int q = 0; q < 4; ++q) { const int c0 = q * 512 + lane * 8; float y[8], vc[8], vp[8], zb[8], f[8];
            unpack8(yr[q], y);
            float s = 0.f;
#pragma unroll
            for (int k = 0; k < 8; ++k) s += y[k];
            const float m = red8(s) * (1.f / 64.f); float s2 = 0.f;
#pragma unroll
            for (int k = 0; k < 8; ++k) { y[k] -= m; s2 += y[k] * y[k]; }
            const float rstd = rsqrtf(red8(s2) * (1.f / 64.f) + 64e-5f);
            unpack8(vcr[q], vc); unpack8(vpr[q], vp); unpack8(zbr[q], zb);
#pragma unroll
            for (int k = 0; k < 8; ++k) { const float v = vc[k] + pmu[q][k >> 2][k & 3] * (vp[k] - vc[k]);
                f[k] = (y[k] * rstd * pg[q][k >> 2][k & 3] + pb[q][k >> 2][k & 3] + ccs[q] * v) * zb[k]; }
            *(u32x4*)(YB + (size_t)row * D + c0) = pack8(f); } }
    for (int idx = blockIdx.x * 512 + tid; idx < NMODROW * SHIFT_W; idx += gridDim.x * 512) { const int rr = idx / SHIFT_W, k = idx % SHIFT_W;
        const size_t srow = rr < 4 ? (size_t)rr * SEQ + SEQ - 1 : (size_t)NTOK_P + rr - 4;
        const float v = bf2f(PROJ[srow * LDP + C_PR + k]);
        if (rr < 4) p->out[O_SHP + (size_t)rr * SHIFT_W + k] = v; else p->out[O_SHS + (size_t)(rr - 4) * SHIFT_W + k] = v; }
}

__device__ void phase9(PP p) {
    const int tid = tid_opaque(), lane = tid & 63, gw = blockIdx.x * 8 + (tid >> 6), nw = gridDim.x * 8; const float* fg = p->in[I_FG];
    const bf16_t* OB = (const bf16_t*)(p->ws + WS_Y);
    f32x4 g[4][2]; u32x4 v[4], vn[4];
#pragma unroll
    for (int i = 0; i < 4; ++i) { g[i][0] = *(const f32x4*)(fg + (lane + 64 * i) * 8); g[i][1] = *(const f32x4*)(fg + (lane + 64 * i) * 8 + 4); }
    if (gw < NTOK) {
#pragma unroll
        for (int i = 0; i < 4; ++i) v[i] = *(const u32x4*)(OB + (size_t)gw * D + (lane + 64 * i) * 8); }
    for (int r = gw; r < NTOK; r += nw) { float* o = p->out + O_Y + (size_t)r * D; const int rn = r + nw;
        if (rn < NTOK) {
#pragma unroll
            for (int i = 0; i < 4; ++i) vn[i] = *(const u32x4*)(OB + (size_t)rn * D + (lane + 64 * i) * 8); }
        float f[4][8]; float ss = 0.f;
#pragma unroll
        for (int i = 0; i < 4; ++i) { unpack8(v[i], f[i]);
#pragma unroll
            for (int q = 0; q < 8; ++q) ss += f[i][q] * f[i][q]; }
        ss = wave_sum(ss); const float rstd = rsqrtf(ss * (1.f / D) + 1e-6f);
#pragma unroll
        for (int i = 0; i < 4; ++i) { const int c = (lane + 64 * i) * 8;
            *(f32x4*)(o + c) = (f32x4){f[i][0], f[i][1], f[i][2], f[i][3]} * rstd * g[i][0]; *(f32x4*)(o + c + 4) = (f32x4){f[i][4], f[i][5], f[i][6], f[i][7]} * rstd * g[i][1]; }
#pragma unroll
        for (int i = 0; i < 4; ++i) v[i] = vn[i];
    }
}

#ifndef DBG_STOP
#define DBG_STOP 99
#endif
__device__ void dbg_dump(PP p) {
    const size_t n = O_CV + 128 * 1024, gt = (size_t)blockIdx.x * 512 + tid_opaque(), gs = (size_t)gridDim.x * 512;
    const bf16_t* w = (const bf16_t*)p->ws;
    for (size_t i = gt; i < n; i += gs) {
        float a = 0.f;
        if (DBG_STOP == 2) { const bf16_t* q = w + WS_PROJ / 2; for (int k = 0; k < 3; ++k) a += bf2f(q[i + (size_t)k * n]); }
        if (DBG_STOP == 1) { const bf16_t* q = w + WS_H / 2; a = bf2f(q[i % ((size_t)MP * D)]); }
        if (DBG_STOP == 0) { const bf16_t* q = w + WS_WTIN / 2; a = bf2f(q[i % ((size_t)LDP * D)]) + bf2f(q[(i + n) % ((size_t)LDP * D)]) + ((const float*)(p->ws + WS_MOD))[i % (NMODROW * 6144)]; }
        if (DBG_STOP == 3) { a = bf2f(w[WS_E / 2 + i % ((size_t)NTOK * D)]) + bf2f(w[WS_AAA / 2 + i % ((size_t)NTOK * D)]) + bf2f(w[WS_YA / 2 + i % ((size_t)NTOK * A_W)]); }
        if (DBG_STOP == 4) { a = bf2f(((const bf16_t*)(p->ws + WS_Y))[i % ((size_t)NTOK_P * D)]) + ((const float*)(p->ws + WS_C))[i % (NTOK_P * 32)]; if (i >= O_WKVP) continue; }
        if (DBG_STOP == 5) { a = bf2f(w[WS_YB / 2 + i % ((size_t)NTOK * D)]); if (i >= O_WKVP) continue; }
        if (DBG_STOP == 7) { a = bf2f(w[WS_MRG / 2 + i % ((size_t)NTOK * D)]); if (i >= O_WKVP) continue; }
        p->out[i] = a;
    }
}

constexpr int NPHASE = 10, LDS_BYTES = 131072 + 16;
__global__ void __launch_bounds__(512) mega(P p_) {
    extern __shared__ __attribute__((aligned(16))) unsigned char shm[];
    LAS unsigned char* lds = (LAS unsigned char*)shm;
    PP p0 = (PP)__builtin_amdgcn_kernarg_segment_ptr();
    const int ph_lo = p0->ph_lo, ph_hi = p0->ph_hi;
    volatile LAS unsigned* st = (volatile LAS unsigned*)(lds + 131072);
    if (threadIdx.x == 0) { st[0] = 0u; st[1] = 0u; st[2] = 0u; st[3] = 0u; }
    __syncthreads();
    const XcdBarrier xb = xcd_barrier_post((unsigned*)(p0->ws + WS_BAR), st);
#ifndef PH_MASK
#define PH_MASK 0x3ff
#endif
#define GSYNC() xcd_barrier(xb)
#define PHASE(n) if (((PH_MASK >> (n)) & 1) && (n) <= DBG_STOP && ph_lo <= (n) && (n) < ph_hi) { if ((n) > ph_lo) GSYNC(); PP p = p0; asm volatile("" : "+s"(p));
#define PHASE_NOSYNC(n) if (((PH_MASK >> (n)) & 1) && (n) <= DBG_STOP && ph_lo <= (n) && (n) < ph_hi) { PP p = p0; asm volatile("" : "+s"(p));
#define PHASE_END }
    PHASE(0) REP(0) { phase0(p, lds); __syncthreads(); } PHASE_END
    PHASE(1) REP(1) phase1(p); PHASE_END
    PHASE(2) REP(2) { pg8::Gemm g{(const bf16_t*)(p->ws + WS_H), (const bf16_t*)(p->ws + WS_WTIN), MP, LDP, D}; pg8::StaticOrder S; S.init(MP, LDP, gridDim.x, blockIdx.x);
        EpiProj E{(bf16_t*)(p->ws + WS_PROJ)}; pg8::gemm_phase(lds, g, S, E); } PHASE_END
#ifdef EXTRA_SYNCS
    for (int i_ = 0; i_ < EXTRA_SYNCS; ++i_) GSYNC();
#endif
    PHASE(3) REP(3) { phase3(p, lds); __syncthreads(); } PHASE_END
    PHASE(4) phase4(p, lds); PHASE_END
    PHASE(5) REP(5) phase5(p); PHASE_END
    PHASE(6) REP(6) { pg8::Gemm g{(const bf16_t*)(p->ws + WS_YA), (const bf16_t*)(p->ws + WS_WTPA), NTOK_P, D, A_W}; pg8::StaticOrder S; S.init(NTOK_P, D, gridDim.x, blockIdx.x);
        EpiMerge<false> E{(bf16_t*)(p->ws + WS_MRG), (const bf16_t*)(p->ws + WS_PROJ) + C_GA}; pg8::gemm_phase(lds, g, S, E);
        bf16_t* mrg = (bf16_t*)(p->ws + WS_MRG) + (size_t)NTOK_P * D; const bf16_t* gp = (const bf16_t*)(p->ws + WS_PROJ) + (size_t)NTOK_P * LDP + C_GA;
        small_gemm((const bf16_t*)(p->ws + WS_YA) + (size_t)NTOK_P * A_W, (const bf16_t*)(p->ws + WS_WTPA), A_W, (LAS float*)lds, [&](const f32x4 acc, int r, int c) {
            const u32x2 g2 = *(const u32x2*)(gp + (size_t)r * LDP + c); u32x2 o; o[0] = cvt_pk_bf16(acc[0] * bflo(g2[0]), acc[1] * bfhi(g2[0])); o[1] = cvt_pk_bf16(acc[2] * bflo(g2[1]), acc[3] * bfhi(g2[1]));
            *(u32x2*)(mrg + (size_t)r * D + c) = o; }); } PHASE_END
    PHASE_NOSYNC(7) { pg8::Gemm g{(const bf16_t*)(p->ws + WS_YB), (const bf16_t*)(p->ws + WS_WTPB), NTOK_P, D, B_W}; pg8::StaticOrder S; S.init(NTOK_P, D, gridDim.x, blockIdx.x);
        EpiMerge<true> E{(bf16_t*)(p->ws + WS_MRG), (const bf16_t*)(p->ws + WS_PROJ) + C_GB}; pg8::gemm_phase(lds, g, S, E);
        bf16_t* mrg = (bf16_t*)(p->ws + WS_MRG) + (size_t)NTOK_P * D; const bf16_t* gp = (const bf16_t*)(p->ws + WS_PROJ) + (size_t)NTOK_P * LDP + C_GB;
        small_gemm((const bf16_t*)(p->ws + WS_YB) + (size_t)NTOK_P * B_W, (const bf16_t*)(p->ws + WS_WTPB), B_W, (LAS float*)lds, [&](const f32x4 acc, int r, int c) {
            const u32x2 g2 = *(const u32x2*)(gp + (size_t)r * LDP + c), m2 = *(const u32x2*)(mrg + (size_t)r * D + c); u32x2 o;
            o[0] = cvt_pk_bf16(bflo(m2[0]) + acc[0] * bflo(g2[0]), bfhi(m2[0]) + acc[1] * bfhi(g2[0])); o[1] = cvt_pk_bf16(bflo(m2[1]) + acc[2] * bflo(g2[1]), bfhi(m2[1]) + acc[3] * bfhi(g2[1]));
            *(u32x2*)(mrg + (size_t)r * D + c) = o; }); } PHASE_END
    PHASE(8) REP(8) { pg8::Gemm g{(const bf16_t*)(p->ws + WS_MRG), (const bf16_t*)(p->ws + WS_WTOUT), NTOK_P, D, D}; pg8::StaticOrder S; S.init(NTOK_P, D, gridDim.x, blockIdx.x);
        EpiOut E{(bf16_t*)(p->ws + WS_Y), p->in[I_XP], p->in[I_XS], (const float*)(p->ws + WS_MOD)}; pg8::gemm_phase(lds, g, S, E);
        bf16_t* os = (bf16_t*)(p->ws + WS_Y) + (size_t)NTOK_P * D; const float* xs = p->in[I_XS]; const float* gate = (const float*)(p->ws + WS_MOD) + (size_t)4 * 6144 + 4096;
        small_gemm((const bf16_t*)(p->ws + WS_MRG) + (size_t)NTOK_P * D, (const bf16_t*)(p->ws + WS_WTOUT), D, (LAS float*)lds, [&](const f32x4 acc, int r, int c) {
            const f32x4 o = *(const f32x4*)(xs + (size_t)r * D + c) + *(const f32x4*)(gate + (size_t)r * 6144 + c) * acc; u32x2 ob; ob[0] = cvt_pk_bf16(o[0], o[1]); ob[1] = cvt_pk_bf16(o[2], o[3]);
            *(u32x2*)(os + (size_t)r * D + c) = ob; }); } PHASE_END
    PHASE(9) phase9(p); PHASE_END
    if (DBG_STOP < 9) { GSYNC(); PP p = p0; asm volatile("" : "+s"(p)); dbg_dump(p); }
}

extern "C" void kernel_launch(void* const* d_in, const int* in_sizes, int n_in, void* d_out, int out_size, void* d_ws, size_t ws_size, hipStream_t stream) {
    static int grid_blocks = 0;
    if (grid_blocks == 0) {
        if (n_in != 28 || ws_size < WS_END) { fprintf(stderr, "kernel_launch: unexpected n_in %d or ws_size %zu (need %zu)\n", n_in, ws_size, (size_t)WS_END); grid_blocks = -1; return; }
        int dev = 0, cus = 0, per_cu = 0;
        (void)hipGetDevice(&dev);
        (void)hipDeviceGetAttribute(&cus, hipDeviceAttributeMultiprocessorCount, dev);
        if (hipFuncSetAttribute((const void*)mega, hipFuncAttributeMaxDynamicSharedMemorySize, LDS_BYTES) != hipSuccess) { fprintf(stderr, "kernel_launch: hipFuncSetAttribute failed\n"); grid_blocks = -1; return; }
        if (hipOccupancyMaxActiveBlocksPerMultiprocessor(&per_cu, (const void*)mega, 512, LDS_BYTES) != hipSuccess || per_cu < 1) { fprintf(stderr, "kernel_launch: occupancy query failed (%d)\n", per_cu); grid_blocks = -1; return; }
        grid_blocks = cus * per_cu;
    }
    if (grid_blocks < 0) return;
    if (hipMemsetAsync((unsigned char*)d_ws + WS_BAR, 0, XCD_BAR_WORDS_C * 4, stream) != hipSuccess) { fprintf(stderr, "kernel_launch: memset of barrier words failed\n"); return; }
    P p{};
    for (int i = 0; i < 28; ++i) p.in[i] = (const float*)d_in[i];
    p.out = (float*)d_out; p.ws = (unsigned char*)d_ws;
#if N_LAUNCH_PER_PHASE
    for (int ph = 0; ph < NPHASE; ++ph) { p.ph_lo = ph; p.ph_hi = ph + 1; void* args[] = {&p};
        hipError_t e = hipLaunchCooperativeKernel((const void*)mega, dim3(grid_blocks), dim3(512), args, LDS_BYTES, stream);
        if (e != hipSuccess) { fprintf(stderr, "cooperative launch failed: %s (grid %d)\n", hipGetErrorString(e), grid_blocks); return; } }
#else
    p.ph_lo = 0; p.ph_hi = NPHASE; void* args[] = {&p};
    hipError_t e = hipLaunchCooperativeKernel((const void*)mega, dim3(grid_blocks), dim3(512), args, LDS_BYTES, stream);
    if (e != hipSuccess) fprintf(stderr, "cooperative launch failed: %s (grid %d)\n", hipGetErrorString(e), grid_blocks);
#endif
}
```

```cpp
#include <hip/hip_runtime.h>
#include <cstdio>

#ifndef REP_MASK
#define REP_MASK 0
#endif
#define REP(n) for (int rep_ = 0; rep_ < (((REP_MASK >> (n)) & 1) ? 2 : 1); ++rep_)
#ifndef N_LAUNCH_PER_PHASE
#define N_LAUNCH_PER_PHASE 0
#endif

#define LAS __attribute__((address_space(3)))
typedef unsigned short bf16_t;
typedef short bf16x8 __attribute__((ext_vector_type(8)));
typedef float f32x4 __attribute__((ext_vector_type(4)));
typedef float f32x2 __attribute__((ext_vector_type(2)));
typedef unsigned u32x4 __attribute__((ext_vector_type(4)));
typedef unsigned u32x2 __attribute__((ext_vector_type(2)));

constexpr int D = 2048, NTOK_P = 8192, NTOK_S = 128, NTOK = 8320, MP = 8448, SEQ = 2048;
constexpr int A_W = 1024, B_W = 2048, SHIFT_W = 6336, IN_W = 15552;
constexpr int LDP = 15616;
constexpr int C_UA = 0, C_VA = 1024, C_ZA = 2048, C_PR = 3072, C_ZB = 9472, C_GA = 11520, C_GB = 13568;
constexpr int PR_R = 0, PR_WD = 2048, PR_K = 2144, PR_V = 4192, PR_AD = 6240;
constexpr int NMODROW = 132, XCD_BAR_WORDS_C = 3456;

constexpr size_t SZ_WTIN = (size_t)LDP * D * 2, SZ_H = (size_t)MP * D * 2;
constexpr size_t WS_WTIN = 0, WS_H = WS_WTIN + SZ_WTIN;
constexpr size_t WS_E = 0, WS_AAA = WS_E + (size_t)NTOK * D * 2, WS_YA = WS_AAA + (size_t)NTOK * D * 2, WS_YB = 0;
constexpr size_t WS_PROJ = WS_H + SZ_H, SZ_PROJ = (size_t)MP * LDP * 2;
constexpr size_t WS_WTPA = WS_PROJ + SZ_PROJ, WS_WTPB = WS_WTPA + (size_t)D * A_W * 2, WS_WTOUT = WS_WTPB + (size_t)D * B_W * 2;
constexpr size_t WS_W2T = WS_WTOUT + (size_t)D * D * 2, WS_A2T = WS_W2T + (size_t)B_W * 96 * 2;
constexpr size_t WS_MOD = WS_A2T + (size_t)B_W * 96 * 2, WS_C = WS_MOD + (size_t)NMODROW * 6144 * 4;
constexpr size_t WS_Y = WS_C + (size_t)NTOK_P * 32 * 4, WS_MRG = WS_Y + (size_t)NTOK_P * D * 4, WS_ES = WS_MRG + SZ_H, WS_BAR = WS_ES + (size_t)NTOK_S * D * 2, WS_END = WS_BAR + XCD_BAR_WORDS_C * 4;
static_assert(WS_YA + (size_t)MP * A_W * 2 <= WS_PROJ, "alias region overflow");

constexpr size_t O_Y = 0, O_WKVP = (size_t)NTOK * D, O_SHP = O_WKVP + 4 * 32 * 4096, O_WKVS = O_SHP + 4 * SHIFT_W, O_SHS = O_WKVS + (size_t)128 * 32 * 4096,
                 O_CV = O_SHS + (size_t)128 * SHIFT_W;

struct P {
    const float* in[28];
    float* out;
    unsigned char* ws;
    int ph_lo, ph_hi;
};
typedef const __attribute__((address_space(4))) P* PP;
enum { I_XP = 0, I_XS, I_CP, I_CS, I_SWKV, I_SSH, I_NORMG, I_WC, I_BC, I_WIN, I_LNG, I_LNB, I_WS, I_BS, I_MU, I_W0, I_W2, I_A0, I_A2, I_KK, I_KA, I_RK, I_GNG, I_GNB,
       I_PA, I_PB, I_WOUT, I_FG };

typedef __bf16 bf16x2_t __attribute__((ext_vector_type(2)));
__device__ __forceinline__ unsigned cvt_pk_bf16(float lo, float hi) { const f32x2 v = {lo, hi}; const bf16x2_t b = __builtin_convertvector(v, bf16x2_t); return __builtin_bit_cast(unsigned, b); }
__device__ __forceinline__ bf16_t f2bf(float f) { return (bf16_t)(cvt_pk_bf16(f, 0.f) & 0xffffu); }
__device__ __forceinline__ float bf2f(bf16_t b) { return __uint_as_float(((unsigned)b) << 16); }
__device__ __forceinline__ float bflo(unsigned u) { return __uint_as_float(u << 16); }
__device__ __forceinline__ float bfhi(unsigned u) { return __uint_as_float(u & 0xffff0000u); }
__device__ __forceinline__ int tid_opaque() { int t = threadIdx.x; asm volatile("" : "+v"(t)); return t; }
template <int CTRL> __device__ __forceinline__ float dppf(float x) { return __int_as_float(__builtin_amdgcn_update_dpp(0, __float_as_int(x), CTRL, 0xf, 0xf, false)); }
__device__ __forceinline__ float red8(float x) { x += dppf<0xB1>(x); x += dppf<0x4E>(x); x += dppf<0x141>(x); return x; }
__device__ __forceinline__ float wave_sum(float v) {
    v += dppf<0xB1>(v); v += dppf<0x4E>(v); v += dppf<0x141>(v); v += dppf<0x140>(v);
    const int iv = __float_as_int(v);
    return (__int_as_float(__builtin_amdgcn_readlane(iv, 0)) + __int_as_float(__builtin_amdgcn_readlane(iv, 16))) + (__int_as_float(__builtin_amdgcn_readlane(iv, 32)) + __int_as_float(__builtin_amdgcn_readlane(iv, 48)));
}
__device__ __forceinline__ float sigmoid_f(float x) { return __builtin_amdgcn_rcpf(1.f + __builtin_amdgcn_exp2f(-1.4426950408889634f * x)); }
__device__ __forceinline__ float tanh_fast(float x) { return 1.f - 2.f * __builtin_amdgcn_rcpf(1.f + __builtin_amdgcn_exp2f(2.8853900817779268f * x)); }
__device__ __forceinline__ float gelu_tanh_f(float x) { return x * sigmoid_f(1.5957691216057308f * (x + 0.044715f * x * x * x)); }
__device__ __forceinline__ float silu_f(float x) { return x * sigmoid_f(x); }
__device__ __forceinline__ void unpack8(const u32x4 r, float (&f)[8]) {
    f[0] = bflo(r[0]); f[1] = bfhi(r[0]); f[2] = bflo(r[1]); f[3] = bfhi(r[1]); f[4] = bflo(r[2]); f[5] = bfhi(r[2]); f[6] = bflo(r[3]); f[7] = bfhi(r[3]);
}
__device__ __forceinline__ u32x4 pack8(const float (&f)[8]) { u32x4 r; r[0] = cvt_pk_bf16(f[0], f[1]); r[1] = cvt_pk_bf16(f[2], f[3]); r[2] = cvt_pk_bf16(f[4], f[5]); r[3] = cvt_pk_bf16(f[6], f[7]); return r; }


#define XB_TMO      128
#define XB_XCNT(j)  (256  + 64 * (j))
#define XB_XSUB(j)  (1280 + 64 * (j))
#define XB_XGEN(j)  (2304 + 64 * (j))
#define XB_TOP      3328
#define XB_TOPGEN   3392
#define XCD_BAR_WORDS 3456
#define XB_SPIN_CAP (1u << 18)
__device__ __forceinline__ unsigned xb_ld(unsigned* p)              { return __hip_atomic_load(p, __ATOMIC_RELAXED, __HIP_MEMORY_SCOPE_AGENT); }
__device__ __forceinline__ unsigned xb_add(unsigned* p, unsigned v) { return __hip_atomic_fetch_add(p, v, __ATOMIC_RELAXED, __HIP_MEMORY_SCOPE_AGENT); }
__device__ __forceinline__ unsigned xb_xcc_id() { return (unsigned)__builtin_amdgcn_s_getreg((3 << 11) | 20) & 0xFu; }
#define XB_SPIN(cond, bar) do { unsigned _sp = 0; while (cond) { __builtin_amdgcn_s_sleep(1); \
    if ((++_sp & 255u) == 0u) { if (xb_ld(&(bar)[XB_TMO])) break; if (_sp > XB_SPIN_CAP) { atomicAdd(&(bar)[XB_TMO], 1u); break; } } } } while (0)
struct XcdBarrier { unsigned* bar; unsigned x; volatile LAS unsigned* st; };
__device__ __forceinline__ XcdBarrier xcd_barrier_post(unsigned* bar, volatile LAS unsigned* st) {
    XcdBarrier b; b.bar = bar; b.x = xb_xcc_id(); b.st = st;
    if (threadIdx.x == 0) (void)xb_add(&bar[XB_XCNT(b.x)], 1u);
    return b;
}
__device__ __forceinline__ void xcd_barrier_complete(unsigned* bar, unsigned x, unsigned& nloc, unsigned& nx) {
    const unsigned G = gridDim.x * gridDim.y * gridDim.z;
    unsigned sum, cnt, mine, sp = 0u;
    for (;;) {
        sum = 0u; cnt = 0u; mine = 0u;
#pragma unroll
        for (unsigned j = 0; j < 16; ++j) { const unsigned c = xb_ld(&bar[XB_XCNT(j)]); sum += c; cnt += (c > 0u) ? 1u : 0u; mine = (j == x) ? c : mine; }
        if (sum == G) break;
        __builtin_amdgcn_s_sleep(1);
        if ((++sp & 255u) == 0u) { if (xb_ld(&bar[XB_TMO])) break; if (sp > XB_SPIN_CAP) { atomicAdd(&bar[XB_TMO], 1u); break; } }
    }
    nloc = mine > 0u ? mine : 1u; nx = cnt > 0u ? cnt : 1u;
}
__device__ __forceinline__ void xcd_barrier(const XcdBarrier& b) {
    asm volatile("s_waitcnt vmcnt(0)" ::: "memory");
    __syncthreads();
    if (threadIdx.x == 0) {
        unsigned* bar = b.bar;
        __builtin_amdgcn_s_waitcnt(0);
        unsigned nloc = b.st[0], nx = b.st[1];
        if (nloc == 0u) { xcd_barrier_complete(bar, b.x, nloc, nx); b.st[0] = nloc; b.st[1] = nx; }
        const unsigned old = xb_add(&bar[XB_XSUB(b.x)], 1u);
        const unsigned gen = old / nloc;
        if (old + 1u == (gen + 1u) * nloc) {
            __builtin_amdgcn_fence(__ATOMIC_RELEASE, "agent");
            asm volatile("s_waitcnt vmcnt(0)" ::: "memory");
            const unsigned og = xb_add(&bar[XB_TOP], 1u);
            const unsigned tg = og / nx;
            if (og + 1u == (tg + 1u) * nx) xb_add(&bar[XB_TOPGEN], 1u);
            else XB_SPIN(xb_ld(&bar[XB_TOPGEN]) == tg, bar);
            __builtin_amdgcn_fence(__ATOMIC_ACQUIRE, "agent");
            xb_add(&bar[XB_XGEN(b.x)], 1u);
            asm volatile("s_waitcnt vmcnt(0)" ::: "memory");
        } else {
            XB_SPIN(xb_ld(&bar[XB_XGEN(b.x)]) == gen, bar);
            __builtin_amdgcn_fence(__ATOMIC_ACQUIRE, "agent");
            asm volatile("s_waitcnt vmcnt(0)" ::: "memory");
        }
    }
    __syncthreads();
}

namespace pg8 {
constexpr int BM = 256, BK = 64, HALF = 128, HTB = HALF * BK * 2, STAGE_BYTES = 8 * HTB, NXCD = 8, WGM = 2;
__device__ __forceinline__ int lds_byte(int r, int c) { const int st = (r >> 4) * 2 + (c >> 5), rr = r & 15, cc = c & 31, ob = rr * 64 + cc * 2; return st * 1024 + (ob ^ (((ob >> 9) & 1) << 5)); }
__device__ __forceinline__ void stage_rc(int b, int& R, int& C) { const int st = b / 1024, sb = b % 1024, swz = sb ^ (((sb >> 9) & 1) << 5); R = (st >> 1) * 16 + swz / 64; C = (st & 1) * 32 + (swz % 64) / 2; }
__device__ __forceinline__ int perm32(int rho) { const int n = rho >> 4, i = rho & 15; return 8 * (i >> 2) + 4 * n + (i & 3); }
struct Unit { int pm, pn; };
struct Gemm { const bf16_t* A; const bf16_t* Bt; int M, N, K; };
struct StaticOrder {
    int nM, nN, nwg, G, c;
    __device__ void init(int M, int N, int G_, int c_) { nM = M / BM; nN = N / BM; nwg = nM * nN; G = G_; c = c_; }
    __device__ bool next(int i, Unit& u) const {
        const long L = (long)i * G + c; if (L >= nwg) return false;
        int wgid = (int)L; { const int q = nwg / NXCD, r = nwg % NXCD, xcd = wgid % NXCD, off = wgid / NXCD; wgid = (xcd < r ? xcd * (q + 1) : r * (q + 1) + (xcd - r) * q) + off; }
        const int nig = WGM * nN, gid = wgid / nig, fm = gid * WGM, gsz = (nM - fm) < WGM ? (nM - fm) : WGM;
        u.pm = fm + ((wgid % nig) % gsz); u.pn = (wgid % nig) / gsz; return true;
    }
};

template <class Epi>
__device__ __forceinline__ void gemm_phase(LAS unsigned char* lds, const Gemm g, const StaticOrder& S, const Epi& E) {
    const int tid = tid_opaque(), wid = __builtin_amdgcn_readfirstlane(tid >> 6), lane = tid & 63, wr = wid >> 2, wc = wid & 3, fr = lane & 15, fq = lane >> 4;
    const int K = g.K, nt = K / BK;
    unsigned voffA[2], voffB[2];
#pragma unroll
    for (int i = 0; i < 2; ++i) { int R, C; stage_rc(tid * 16 + i * 8192, R, C); const int Rb = Epi::PERM ? ((R & ~31) + perm32(R & 31)) : R;
        voffA[i] = (unsigned)(R * K + C) * 2u; voffB[i] = (unsigned)(Rb * K + C) * 2u; }
    const size_t kstep = (size_t)(BK * 2);
    const size_t hstep = (size_t)HALF * K * 2;
    const size_t tstep = 2 * hstep;
    const unsigned ldsw = (unsigned)wid * 1024u;
    const int aoff = lds_byte(wr * 64 + fr, fq * 8), boff = lds_byte(wc * 32 + fr, fq * 8);
#define PG8_SA(b, h) (((b) * 2 + (h)) * HTB)
#define PG8_SB(b, h) ((4 + (b) * 2 + (h)) * HTB)
#define PG8_STAGE(bufoff, gbase, voff) do { _Pragma("unroll") for (int _i = 0; _i < 2; ++_i) \
        __builtin_amdgcn_global_load_lds((const unsigned*)((const char*)(gbase) + (voff)[_i]), (LAS unsigned*)(lds + (bufoff) + ldsw + _i * 8192), 16, 0, 0); } while (0)
#define PG8_LDA(dst, b, h) do { _Pragma("unroll") for (int m = 0; m < 4; ++m) _Pragma("unroll") for (int k = 0; k < 2; ++k) dst[m][k] = *(const LAS bf16x8*)(lds + PG8_SA(b, h) + aoff + m * 2048 + k * 1024); } while (0)
#define PG8_LDB(dst, b, h) do { _Pragma("unroll") for (int n = 0; n < 2; ++n) _Pragma("unroll") for (int k = 0; k < 2; ++k) dst[n][k] = *(const LAS bf16x8*)(lds + PG8_SB(b, h) + boff + n * 2048 + k * 1024); } while (0)
#define PG8_MMA(ai, bj, At, Bt) do { __builtin_amdgcn_s_setprio(1); _Pragma("unroll") for (int m = 0; m < 4; ++m) _Pragma("unroll") for (int n = 0; n < 2; ++n) _Pragma("unroll") for (int k = 0; k < 2; ++k) \
        acc[ai][bj][m][n] = __builtin_amdgcn_mfma_f32_16x16x32_bf16(Bt[n][k], At[m][k], acc[ai][bj][m][n], 0, 0, 0); __builtin_amdgcn_s_setprio(0); } while (0)
#define PG8_WAIT_V(n) asm volatile("s_waitcnt vmcnt(" #n ")" ::: "memory")
#define PG8_WAIT_L(n) asm volatile("s_waitcnt lgkmcnt(" #n ")" ::: "memory")
#define PG8_BAR __builtin_amdgcn_s_barrier()
#define PG8_SCHED __builtin_amdgcn_sched_barrier(0)
    Unit cur, nxt; int ui = 0;
    if (!S.next(0, cur)) return;
    f32x4 acc[2][2][4][2];
#pragma unroll
    for (int a = 0; a < 2; ++a)
#pragma unroll
        for (int b = 0; b < 2; ++b)
#pragma unroll
            for (int m = 0; m < 4; ++m)
#pragma unroll
                for (int n = 0; n < 2; ++n) acc[a][b][m][n] = (f32x4){0.f, 0.f, 0.f, 0.f};
    bf16x8 At[4][2], B0[2][2], B1[2][2];
    const char* cA = (const char*)g.A + (size_t)cur.pm * tstep; const char* cB = (const char*)g.Bt + (size_t)cur.pn * tstep;
    PG8_STAGE(PG8_SB(0, 0), cB, voffB); PG8_STAGE(PG8_SA(0, 0), cA, voffA); PG8_STAGE(PG8_SB(0, 1), cB + hstep, voffB); PG8_STAGE(PG8_SA(0, 1), cA + hstep, voffA);
    if (wr == 1) PG8_BAR;
    PG8_WAIT_V(4); PG8_BAR;
    PG8_STAGE(PG8_SB(1, 0), cB + kstep, voffB); PG8_STAGE(PG8_SA(1, 0), cA + kstep, voffA); PG8_STAGE(PG8_SB(1, 1), cB + hstep + kstep, voffB);
    PG8_WAIT_V(6); PG8_BAR;
    for (;;) {
        const bool has_next = S.next(ui + 1, nxt);
        const char* nA = has_next ? (const char*)g.A + (size_t)nxt.pm * tstep : cA; const char* nB = has_next ? (const char*)g.Bt + (size_t)nxt.pn * tstep : cB;
        for (int t = 0; t < nt; t += 2) {
            const bool last = (t == nt - 2);
            const char* a1 = cA + (size_t)(t + 1) * kstep;
            const char* a2 = last ? nA : cA + (size_t)(t + 2) * kstep; const char* b2 = last ? nB : cB + (size_t)(t + 2) * kstep;
            const char* a3 = a2 + kstep; const char* b3 = b2 + kstep;
            PG8_LDB(B0, 0, 0); PG8_SCHED; PG8_LDA(At, 0, 0); PG8_STAGE(PG8_SA(1, 1), a1 + hstep, voffA);
            PG8_WAIT_L(8); PG8_BAR; PG8_WAIT_L(0); PG8_MMA(0, 0, At, B0); PG8_BAR; PG8_SCHED;
            PG8_LDB(B1, 0, 1); PG8_STAGE(PG8_SB(0, 0), b2, voffB);
            PG8_BAR; PG8_WAIT_L(0); PG8_MMA(0, 1, At, B1); PG8_BAR;
            PG8_LDA(At, 0, 1); PG8_STAGE(PG8_SA(0, 0), a2, voffA);
            PG8_BAR; PG8_WAIT_L(0); PG8_MMA(1, 0, At, B0); PG8_BAR; PG8_SCHED;
            PG8_STAGE(PG8_SB(0, 1), b2 + hstep, voffB);
            PG8_WAIT_V(6); PG8_BAR; PG8_MMA(1, 1, At, B1); PG8_BAR;
            PG8_LDB(B0, 1, 0); PG8_SCHED; PG8_LDA(At, 1, 0); PG8_STAGE(PG8_SA(0, 1), a2 + hstep, voffA);
            PG8_WAIT_L(8); PG8_BAR; PG8_WAIT_L(0); PG8_MMA(0, 0, At, B0); PG8_BAR; PG8_SCHED;
            PG8_LDB(B1, 1, 1); PG8_STAGE(PG8_SB(1, 0), b3, voffB);
            PG8_BAR; PG8_WAIT_L(0); PG8_MMA(0, 1, At, B1); PG8_BAR;
            PG8_LDA(At, 1, 1); PG8_STAGE(PG8_SA(1, 0), a3, voffA);
            PG8_BAR; PG8_WAIT_L(0); PG8_MMA(1, 0, At, B0); PG8_BAR; PG8_SCHED;
            PG8_STAGE(PG8_SB(1, 1), b3 + hstep, voffB);
            PG8_WAIT_V(6); PG8_BAR; PG8_MMA(1, 1, At, B1); PG8_BAR;
        }
        E(acc, cur, wr, wc, fr, fq);
        if (!has_next) break;
#pragma unroll
        for (int a = 0; a < 2; ++a)
#pragma unroll
            for (int b = 0; b < 2; ++b)
#pragma unroll
                for (int m = 0; m < 4; ++m)
#pragma unroll
                    for (int n = 0; n < 2; ++n) acc[a][b][m][n] = (f32x4){0.f, 0.f, 0.f, 0.f};
        cur = nxt; cA = nA; cB = nB; ++ui;
    }
    PG8_WAIT_V(0);
    if (wr == 0) PG8_BAR;
    PG8_BAR;
#undef PG8_SA
#undef PG8_SB
#undef PG8_STAGE
#undef PG8_LDA
#undef PG8_LDB
#undef PG8_MMA
#undef PG8_WAIT_V
#undef PG8_WAIT_L
#undef PG8_BAR
#undef PG8_SCHED
}
}

struct EpiProj {
    static constexpr bool PERM = true;
    bf16_t* O;
    template <int MODE> __device__ __forceinline__ void run(const f32x4 (&acc)[2][2][4][2], const pg8::Unit& u, int wr, int wc, int fr, int fq) const {
        const int row0 = u.pm * 256 + wr * 64 + fr, col0 = u.pn * 256 + wc * 32 + 8 * fq;
#pragma unroll
        for (int ai = 0; ai < 2; ++ai)
#pragma unroll
            for (int m = 0; m < 4; ++m) { bf16_t* rowp = O + (size_t)(row0 + ai * 128 + m * 16) * LDP + col0;
#pragma unroll
                for (int bj = 0; bj < 2; ++bj) { float f[8];
#pragma unroll
                    for (int q = 0; q < 8; ++q) { const float x = acc[ai][bj][m][q >> 2][q & 3];
                        f[q] = MODE == 0 ? gelu_tanh_f(x) : MODE == 1 ? silu_f(x) : MODE == 2 ? x : sigmoid_f(x); }
                    *(u32x4*)(rowp + bj * 128) = pack8(f); } }
    }
    __device__ __forceinline__ void operator()(const f32x4 (&acc)[2][2][4][2], const pg8::Unit& u, int wr, int wc, int fr, int fq) const {
        const int pn = u.pn;
        if (pn < 8) run<0>(acc, u, wr, wc, fr, fq);
        else if (pn < 12) run<1>(acc, u, wr, wc, fr, fq);
        else if (pn < 37) run<2>(acc, u, wr, wc, fr, fq);
        else if (pn < 45) run<1>(acc, u, wr, wc, fr, fq);
        else run<3>(acc, u, wr, wc, fr, fq);
    }
};
template <bool ADD> struct EpiMerge {
    static constexpr bool PERM = true;
    bf16_t* O; const bf16_t* G;
    __device__ __forceinline__ void operator()(const f32x4 (&acc)[2][2][4][2], const pg8::Unit& u, int wr, int wc, int fr, int fq) const {
        const int row0 = u.pm * 256 + wr * 64 + fr, col0 = u.pn * 256 + wc * 32 + 8 * fq;
#pragma unroll
        for (int ai = 0; ai < 2; ++ai)
#pragma unroll
            for (int m = 0; m < 4; ++m) { const size_t r = (size_t)(row0 + ai * 128 + m * 16);
#pragma unroll
                for (int bj = 0; bj < 2; ++bj) { const int c = col0 + bj * 128; float gt[8], f[8];
                    unpack8(*(const u32x4*)(G + r * LDP + c), gt);
                    if (ADD) unpack8(*(const u32x4*)(O + r * D + c), f);
#pragma unroll
                    for (int q = 0; q < 8; ++q) { const float x = acc[ai][bj][m][q >> 2][q & 3] * gt[q]; f[q] = ADD ? f[q] + x : x; }
                    *(u32x4*)(O + r * D + c) = pack8(f); } }
    }
};
struct EpiOut {
    static constexpr bool PERM = true;
    bf16_t* O; const float* xp; const float* xs; const float* mod;
    __device__ __forceinline__ void operator()(const f32x4 (&acc)[2][2][4][2], const pg8::Unit& u, int wr, int wc, int fr, int fq) const {
        const int row0 = u.pm * 256 + wr * 64 + fr, col0 = u.pn * 256 + wc * 32 + 8 * fq;
#pragma unroll
        for (int ai = 0; ai < 2; ++ai)
#pragma unroll
            for (int m = 0; m < 4; ++m) { const int r = row0 + ai * 128 + m * 16;
                if (r < NTOK) { const float* x = r < NTOK_P ? xp + (size_t)r * D : xs + (size_t)(r - NTOK_P) * D; const int b = r < NTOK_P ? (r >> 11) : 4 + (r - NTOK_P);
                    const float* gate = mod + (size_t)b * 6144 + 4096;
#pragma unroll
                    for (int bj = 0; bj < 2; ++bj) { const int c = col0 + bj * 128; float f[8];
                        const f32x4 x0 = *(const f32x4*)(x + c), x1 = *(const f32x4*)(x + c + 4), g0 = *(const f32x4*)(gate + c), g1 = *(const f32x4*)(gate + c + 4);
                        const f32x4 o0 = x0 + g0 * acc[ai][bj][m][0], o1 = x1 + g1 * acc[ai][bj][m][1];
                        f[0] = o0[0]; f[1] = o0[1]; f[2] = o0[2]; f[3] = o0[3]; f[4] = o1[0]; f[5] = o1[1]; f[6] = o1[2]; f[7] = o1[3];
                        *(u32x4*)(O + (size_t)r * D + c) = pack8(f); } } }
    }
};

typedef float f32x16 __attribute__((ext_vector_type(16)));
template <class Epi> __device__ __forceinline__ void small_gemm(const bf16_t* __restrict__ A, const bf16_t* __restrict__ Bt, int K, LAS float* red, const Epi& epi) {
    const int tid = tid_opaque(), wid = tid >> 6, lane = tid & 63, l31 = lane & 31, lh = lane >> 5;
    for (int tile = blockIdx.x; tile < 256; tile += gridDim.x) {
        const int r0 = (tile & 3) * 32, n0 = (tile >> 2) * 32, kw = wid * (K >> 3), ns = K >> 7;
        const bf16_t* ap = A + (size_t)(r0 + l31) * K + kw + lh * 8; const bf16_t* bp = Bt + (size_t)(n0 + l31) * K + kw + lh * 8;
        f32x16 acc;
#pragma unroll
        for (int v = 0; v < 16; ++v) acc[v] = 0.f;
#pragma unroll 8
        for (int st = 0; st < ns; ++st) { const bf16x8 af = *(const bf16x8*)(ap + st * 16), bf = *(const bf16x8*)(bp + st * 16);
            acc = __builtin_amdgcn_mfma_f32_32x32x16_bf16(bf, af, acc, 0, 0, 0); }
#pragma unroll
        for (int v = 0; v < 16; ++v) red[(wid * 16 + v) * 64 + lane] = acc[v];
        __syncthreads();
        if (tid < 256) { const int g = tid >> 6; f32x4 sum = (f32x4){0.f, 0.f, 0.f, 0.f};
#pragma unroll
            for (int w = 0; w < 8; ++w)
#pragma unroll
                for (int j = 0; j < 4; ++j) sum[j] += red[(w * 16 + g * 4 + j) * 64 + lane];
            epi(sum, r0 + l31, n0 + 8 * g + 4 * lh); }
        __syncthreads();
    }
}

__device__ void mod_tile(PP p, int tile, LAS float* red) {
    const int tid = tid_opaque(), wid = tid >> 6, lane = tid & 63, fr = lane & 15, fq = lane >> 4, n0 = tile * 32;
    const float* wc = p->in[I_WC];
    f32x4 acc[9][2];
#pragma unroll
    for (int a = 0; a < 9; ++a) { acc[a][0] = (f32x4){0.f, 0.f, 0.f, 0.f}; acc[a][1] = (f32x4){0.f, 0.f, 0.f, 0.f}; }
    float bw[2][8], bn[2][8];
#pragma unroll
    for (int nt = 0; nt < 2; ++nt)
#pragma unroll
        for (int j = 0; j < 8; ++j) bw[nt][j] = wc[(size_t)(wid * 256 + fq * 8 + j) * 6144 + n0 + nt * 16 + fr];
#pragma unroll 1
    for (int ks = 0; ks < 8; ++ks) { const int k0 = wid * 256 + ks * 32 + fq * 8;
        if (ks + 1 < 8) {
#pragma unroll
            for (int nt = 0; nt < 2; ++nt)
#pragma unroll
                for (int j = 0; j < 8; ++j) bn[nt][j] = wc[(size_t)(k0 + 32 + j) * 6144 + n0 + nt * 16 + fr]; }
        f32x4 av[9][2];
#pragma unroll
        for (int mt = 0; mt < 9; ++mt) { const int r = mt * 16 + fr;
            if (r < NMODROW) { const float* cp = (r < 4 ? p->in[I_CP] + (size_t)r * D : p->in[I_CS] + (size_t)(r - 4) * D) + k0; av[mt][0] = *(const f32x4*)cp; av[mt][1] = *(const f32x4*)(cp + 4); }
            else { av[mt][0] = (f32x4){0.f, 0.f, 0.f, 0.f}; av[mt][1] = av[mt][0]; } }
        bf16x8 bfr[2];
#pragma unroll
        for (int nt = 0; nt < 2; ++nt) { const u32x4 pk = pack8(bw[nt]); bfr[nt] = __builtin_bit_cast(bf16x8, pk); }
#pragma unroll
        for (int mt = 0; mt < 9; ++mt) { u32x4 pk; pk[0] = cvt_pk_bf16(av[mt][0][0], av[mt][0][1]); pk[1] = cvt_pk_bf16(av[mt][0][2], av[mt][0][3]); pk[2] = cvt_pk_bf16(av[mt][1][0], av[mt][1][1]); pk[3] = cvt_pk_bf16(av[mt][1][2], av[mt][1][3]);
            const bf16x8 afr = __builtin_bit_cast(bf16x8, pk);
            acc[mt][0] = __builtin_amdgcn_mfma_f32_16x16x32_bf16(afr, bfr[0], acc[mt][0], 0, 0, 0);
            acc[mt][1] = __builtin_amdgcn_mfma_f32_16x16x32_bf16(afr, bfr[1], acc[mt][1], 0, 0, 0); }
#pragma unroll
        for (int nt = 0; nt < 2; ++nt)
#pragma unroll
            for (int j = 0; j < 8; ++j) bw[nt][j] = bn[nt][j];
    }
    if (wid >= 4) {
#pragma unroll
        for (int mt = 0; mt < 9; ++mt)
#pragma unroll
            for (int nt = 0; nt < 2; ++nt)
#pragma unroll
                for (int j = 0; j < 4; ++j) red[(wid - 4) * 4608 + (mt * 16 + fq * 4 + j) * 32 + nt * 16 + fr] = acc[mt][nt][j]; }
    __syncthreads();
    if (wid < 4) {
#pragma unroll
        for (int mt = 0; mt < 9; ++mt)
#pragma unroll
            for (int nt = 0; nt < 2; ++nt)
#pragma unroll
                for (int j = 0; j < 4; ++j) red[wid * 4608 + (mt * 16 + fq * 4 + j) * 32 + nt * 16 + fr] += acc[mt][nt][j]; }
    __syncthreads();
    float* mod = (float*)(p->ws + WS_MOD); const float* bc = p->in[I_BC];
    for (int i = tid; i < NMODROW * 32; i += 512) { const int r = i >> 5, c = i & 31; mod[(size_t)r * 6144 + n0 + c] = ((red[i] + red[4608 + i]) + (red[9216 + i] + red[13824 + i])) + bc[n0 + c]; }
    __syncthreads();
}
constexpr int T0_MOD = 192, T0_WIN = 8 * 243, T0_PA = 4 * 32, T0_PB = 8 * 32, T0_WOUT = 8 * 32, NCONV_ALL = T0_WIN + T0_PA + T0_PB + T0_WOUT;
__device__ __forceinline__ void conv_desc(PP p, int u, const float*& sp, int& Nsrc, bf16_t*& dp, int& K) {
    if (u < T0_WIN) { const int tn = u >> 3, tk = u & 7; Nsrc = IN_W; K = D; sp = p->in[I_WIN] + (size_t)tk * 256 * IN_W + tn * 64; dp = (bf16_t*)(p->ws + WS_WTIN) + (size_t)(tn * 64 + (tn >= 147 ? 64 : 0)) * D + tk * 256; return; }
    u -= T0_WIN; Nsrc = D;
    if (u < T0_PA) { const int tk = u & 3, tn = u >> 2; K = A_W; sp = p->in[I_PA] + (size_t)tk * 256 * D + tn * 64; dp = (bf16_t*)(p->ws + WS_WTPA) + (size_t)tn * 64 * A_W + tk * 256; return; }
    u -= T0_PA; K = D; const int tk = u & 7, tn = (u >> 3) & 31;
    if (u < T0_PB) { sp = p->in[I_PB] + (size_t)tk * 256 * D + tn * 64; dp = (bf16_t*)(p->ws + WS_WTPB) + (size_t)tn * 64 * D + tk * 256; return; }
    { sp = p->in[I_WOUT] + (size_t)tk * 256 * D + tn * 64; dp = (bf16_t*)(p->ws + WS_WTOUT) + (size_t)tn * 64 * D + tk * 256; }
}
__device__ void phase0(PP p, LAS unsigned char* lds) {
    const int tid = tid_opaque();
    REP(13) for (int t = blockIdx.x; t < T0_MOD; t += gridDim.x) mod_tile(p, t, (LAS float*)lds);
    const int rb = gridDim.x - 1 - blockIdx.x;
    if (rb == 0) { u32x4* z = (u32x4*)(p->ws + WS_WTIN + (size_t)9408 * D * 2); for (int i = tid; i < 64 * D * 2 / 16; i += 512) z[i] = (u32x4){0u, 0u, 0u, 0u}; }
    for (int it = blockIdx.x; it < 256; it += gridDim.x) { const int w = it >> 7, n0 = (it & 127) * 16; const float* src = p->in[w ? I_A2 : I_W2]; bf16_t* dst = (bf16_t*)(p->ws + (w ? WS_A2T : WS_W2T));
#pragma unroll
        for (int j = 0; j < 3; ++j) { const int i = tid + j * 512, nl = i / 96, k = i % 96; dst[(size_t)(n0 + nl) * 96 + k] = f2bf(src[(size_t)k * B_W + n0 + nl]); } }
    LAS float* t = (LAS float*)lds; volatile LAS int* slot = (volatile LAS int*)(lds + 256 * 65 * 4);
    unsigned* q = (unsigned*)(p->ws + WS_BAR) + 64;
    __syncthreads();
    if (tid == 0) slot[0] = (int)atomicAdd(q, 2u);
    __syncthreads();
    const int NCONV = (gridDim.x == 256) ? T0_WIN : NCONV_ALL;
    int cur = slot[0], nxt = cur + 1;
    f32x4 rg[8], rn[8];
    auto load = [&](int u, f32x4 (&r)[8]) { const float* sp; int Nsrc, K; bf16_t* dp; conv_desc(p, u, sp, Nsrc, dp, K);
#pragma unroll
        for (int i = 0; i < 8; ++i) { const int idx = tid + i * 512; r[i] = *(const f32x4*)(sp + (size_t)(idx >> 4) * Nsrc + (idx & 15) * 4); } };
    if (cur < NCONV) load(cur, rg);
    while (cur < NCONV) {
        int claimed = 0;
        if (tid == 0) claimed = (int)atomicAdd(q, 1u);
        if (nxt < NCONV) load(nxt, rn);
        __syncthreads();
        if (tid == 0) slot[0] = claimed;
#pragma unroll
        for (int i = 0; i < 8; ++i) { const int idx = tid + i * 512, row = idx >> 4, cb = (idx & 15) * 4, hx = (row >> 5) & 7;
            t[row * 65 + (cb ^ hx)] = rg[i][0]; t[row * 65 + ((cb + 1) ^ hx)] = rg[i][1]; t[row * 65 + ((cb + 2) ^ hx)] = rg[i][2]; t[row * 65 + ((cb + 3) ^ hx)] = rg[i][3]; }
        __syncthreads();
        const int n2 = slot[0];
        { const float* sp; int Nsrc, K; bf16_t* dp; conv_desc(p, cur, sp, Nsrc, dp, K);
#pragma unroll
            for (int i = 0; i < 4; ++i) { const int ch = tid + i * 512, nl = ch >> 5, kc = ch & 31; float f[8];
#pragma unroll
                for (int j = 0; j < 8; ++j) f[j] = t[(kc * 8 + j) * 65 + (nl ^ ((kc >> 2) & 7))];
                *(u32x4*)(dp + (size_t)nl * K + kc * 8) = pack8(f); } }
        cur = nxt; nxt = n2;
#pragma unroll
        for (int i = 0; i < 8; ++i) rg[i] = rn[i];
    }
    __syncthreads();
}

__device__ void phase1(PP p) {
    const int tid = tid_opaque(), lane = tid & 63, gw = blockIdx.x * 8 + (tid >> 6), nw = gridDim.x * 8;
    bf16_t* H = (bf16_t*)(p->ws + WS_H); const float* mod = (const float*)(p->ws + WS_MOD); const float* ng = p->in[I_NORMG];
    f32x4 g[8];
#pragma unroll
    for (int i = 0; i < 8; ++i) g[i] = *(const f32x4*)(ng + (lane + 64 * i) * 4);
    auto xrow = [&](int r) { return r < NTOK_P ? p->in[I_XP] + (size_t)r * D : p->in[I_XS] + (size_t)(r - NTOK_P) * D; };
    f32x4 v[8], vn[8];
    if (gw < NTOK) {
#pragma unroll
        for (int i = 0; i < 8; ++i) v[i] = *(const f32x4*)(xrow(gw) + (lane + 64 * i) * 4); }
    for (int r = gw; r < MP; r += nw) {
        bf16_t* hrow = H + (size_t)r * D;
        if (r >= NTOK) { for (int i = 0; i < 4; ++i) *(u32x4*)(hrow + (lane + 64 * i) * 8) = (u32x4){0u, 0u, 0u, 0u}; continue; }
        const int rn = r + nw;
        if (rn < NTOK) {
#pragma unroll
            for (int i = 0; i < 8; ++i) vn[i] = *(const f32x4*)(xrow(rn) + (lane + 64 * i) * 4); }
        const int b = r < NTOK_P ? (r >> 11) : 4 + (r - NTOK_P);
        const float* mrow = mod + (size_t)b * 6144;
        float ss = 0.f;
#pragma unroll
        for (int i = 0; i < 8; ++i) ss += v[i][0] * v[i][0] + v[i][1] * v[i][1] + v[i][2] * v[i][2] + v[i][3] * v[i][3];
        ss = wave_sum(ss); const float rstd = rsqrtf(ss * (1.f / D) + 1e-6f);
#pragma unroll
        for (int i = 0; i < 8; ++i) { const int c = (lane + 64 * i) * 4; const f32x4 sh = *(const f32x4*)(mrow + c), sc = *(const f32x4*)(mrow + 2048 + c);
            const f32x4 h = v[i] * rstd * g[i] * (sc + 1.f) + sh; u32x2 o; o[0] = cvt_pk_bf16(h[0], h[1]); o[1] = cvt_pk_bf16(h[2], h[3]); *(u32x2*)(hrow + c) = o; }
#pragma unroll
        for (int i = 0; i < 8; ++i) v[i] = vn[i];
    }
}

__device__ void mixa_tile(PP p, int tile, LAS unsigned char* lds) {
    const int tid = tid_opaque(), wid = tid >> 6, lane = tid & 63, fr = lane & 15, fq = lane >> 4;
    const int b = tile >> 7, nck = (tile >> 3) & 15, g = tile & 7, row0 = b * SEQ + nck * 128;
    const bf16_t* PROJ = (const bf16_t*)(p->ws + WS_PROJ); bf16_t* YA = (bf16_t*)(p->ws + WS_YA);
    LAS float* mu = (LAS float*)lds; LAS float* rs = mu + 128;
    LAS bf16_t* wA = (LAS bf16_t*)(lds + 1024); LAS bf16_t* vT = wA + 128 * 136;
#pragma unroll
    for (int hb = 0; hb < 2; ++hb) { u32x4 ra[8], rc[8];
#pragma unroll
        for (int k = 0; k < 8; ++k) { const bf16_t* vr = PROJ + (size_t)(row0 + wid * 16 + hb * 8 + k) * LDP + C_VA; ra[k] = *(const u32x4*)(vr + lane * 8); rc[k] = *(const u32x4*)(vr + 512 + lane * 8); }
#pragma unroll
        for (int k = 0; k < 8; ++k) { float a[8], c[8]; unpack8(ra[k], a); unpack8(rc[k], c); float s = 0.f, s2 = 0.f;
#pragma unroll
            for (int q = 0; q < 8; ++q) { s += a[q] + c[q]; s2 += a[q] * a[q] + c[q] * c[q]; }
            s = wave_sum(s); s2 = wave_sum(s2); const float m = s * (1.f / A_W), var = fmaxf(s2 * (1.f / A_W) - m * m, 0.f);
            if (lane == 0) { const int tl = wid * 16 + hb * 8 + k; mu[tl] = m; rs[tl] = rsqrtf(var + 1e-6f); } } }
    const float* wsrc = p->in[I_WS] + (size_t)g * 128 * 128;
#pragma unroll
    for (int i = 0; i < 8; ++i) { const int idx = tid + i * 512, t = idx >> 5, s4 = (idx & 31) * 4; const f32x4 w = *(const f32x4*)(wsrc + t * 128 + s4);
        u32x2 o; o[0] = cvt_pk_bf16(s4 <= t ? w[0] : 0.f, s4 + 1 <= t ? w[1] : 0.f); o[1] = cvt_pk_bf16(s4 + 2 <= t ? w[2] : 0.f, s4 + 3 <= t ? w[3] : 0.f);
        *(LAS u32x2*)(wA + t * 136 + s4) = o; }
    __syncthreads();
    const float* lng = p->in[I_LNG] + g * 128; const float* lnb = p->in[I_LNB] + g * 128;
    u32x2 uar[8], zar[8];
    { const int rowe = row0 + wid * 16 + fr;
#pragma unroll
      for (int ct = 0; ct < 8; ++ct) { const int c = g * 128 + ct * 16 + fq * 4; uar[ct] = *(const u32x2*)(PROJ + (size_t)rowe * LDP + C_UA + c); zar[ct] = *(const u32x2*)(PROJ + (size_t)rowe * LDP + C_ZA + c); } }
#pragma unroll
    for (int i = 0; i < 4; ++i) { const int idx = tid + i * 512, s = idx >> 4, c8 = (idx & 15) * 8; float x[8];
        unpack8(*(const u32x4*)(PROJ + (size_t)(row0 + s) * LDP + C_VA + g * 128 + c8), x); const float m = mu[s], r = rs[s];
        const f32x4 g0 = *(const f32x4*)(lng + c8), g1 = *(const f32x4*)(lng + c8 + 4), b0 = *(const f32x4*)(lnb + c8), b1 = *(const f32x4*)(lnb + c8 + 4);
        const int ssw = s ^ (((c8 >> 3) & 7) << 3);
#pragma unroll
        for (int q = 0; q < 8; ++q) vT[(c8 + q) * 136 + ssw] = f2bf((x[q] - m) * r * (q < 4 ? g0[q & 3] : g1[q & 3]) + (q < 4 ? b0[q & 3] : b1[q & 3])); }
    __syncthreads();
    const int t0 = wid * 16, nks = (t0 + 15) / 32 + 1;
    bf16x8 af[4];
#pragma unroll
    for (int ks = 0; ks < 4; ++ks) af[ks] = *(const LAS bf16x8*)(wA + (t0 + fr) * 136 + (ks < nks ? ks : 0) * 32 + fq * 8);
    const int row = row0 + t0 + fr; const float bias = p->in[I_BS][g * 128 + t0 + fr];
#pragma unroll
    for (int ct = 0; ct < 8; ++ct) { f32x4 acc = (f32x4){0.f, 0.f, 0.f, 0.f};
#pragma unroll
        for (int ks = 0; ks < 4; ++ks) if (ks < nks) { const int cch = ct * 16 + fr; const bf16x8 bfr = *(const LAS bf16x8*)(vT + cch * 136 + ((ks * 32 + fq * 8) ^ (((cch >> 3) & 7) << 3)));
            acc = __builtin_amdgcn_mfma_f32_16x16x32_bf16(bfr, af[ks], acc, 0, 0, 0); }
        const int c = g * 128 + ct * 16 + fq * 4;
        const u32x2 ua = uar[ct], za = zar[ct];
        u32x2 o; o[0] = cvt_pk_bf16(bflo(ua[0]) * (acc[0] + bias) * bflo(za[0]), bfhi(ua[0]) * (acc[1] + bias) * bfhi(za[0]));
        o[1] = cvt_pk_bf16(bflo(ua[1]) * (acc[2] + bias) * bflo(za[1]), bfhi(ua[1]) * (acc[3] + bias) * bfhi(za[1]));
        *(u32x2*)(YA + (size_t)row * A_W + c) = o; }
    __syncthreads();
}
__device__ void mixa_sample_row(PP p, int bs) {
    const int lane = tid_opaque() & 63, row = NTOK_P + bs;
    const bf16_t* pr = (const bf16_t*)(p->ws + WS_PROJ) + (size_t)row * LDP; bf16_t* YA = (bf16_t*)(p->ws + WS_YA) + (size_t)row * A_W; float* cv = p->out + O_CV + (size_t)bs * A_W;
    float x[2][8]; unpack8(*(const u32x4*)(pr + C_VA + lane * 8), x[0]); unpack8(*(const u32x4*)(pr + C_VA + 512 + lane * 8), x[1]);
    float s = 0.f, s2 = 0.f;
#pragma unroll
    for (int q = 0; q < 8; ++q) { s += x[0][q] + x[1][q]; s2 += x[0][q] * x[0][q] + x[1][q] * x[1][q]; }
    s = wave_sum(s); s2 = wave_sum(s2); const float m = s * (1.f / A_W), r = rsqrtf(fmaxf(s2 * (1.f / A_W) - m * m, 0.f) + 1e-6f);
#pragma unroll
    for (int hlf = 0; hlf < 2; ++hlf) { const int c0 = hlf * 512 + lane * 8, g = c0 >> 7; const float w00 = p->in[I_WS][(size_t)g * 128 * 128], b0 = p->in[I_BS][g * 128];
        float ua[8], za[8], f[8], vn[8]; unpack8(*(const u32x4*)(pr + C_UA + c0), ua); unpack8(*(const u32x4*)(pr + C_ZA + c0), za);
#pragma unroll
        for (int q = 0; q < 8; ++q) { vn[q] = (x[hlf][q] - m) * r * p->in[I_LNG][c0 + q] + p->in[I_LNB][c0 + q]; f[q] = ua[q] * (w00 * vn[q] + b0) * za[q]; }
        *(f32x4*)(cv + c0) = (f32x4){vn[0], vn[1], vn[2], vn[3]}; *(f32x4*)(cv + c0 + 4) = (f32x4){vn[4], vn[5], vn[6], vn[7]};
        *(u32x4*)(YA + c0) = pack8(f); }
}

template <bool SMP> __device__ __forceinline__ void lora_stage(PP p, int T0, int tid, LAS bf16_t* Aw, LAS bf16_t* Aa) {
    const bf16_t* PROJ = (const bf16_t*)(p->ws + WS_PROJ); const float* mu = p->in[I_MU];
#pragma unroll 1
    for (int hb = 0; hb < 2; ++hb) {
        u32x4 cur[4], prv[4]; f32x4 pf0[4], pf1[4];
#pragma unroll
        for (int k = 0; k < 4; ++k) { const int idx = tid + (hb * 4 + k) * 512, which = idx >= 144 * 12, i2 = which ? idx - 144 * 12 : idx, tl = i2 / 12, ch = i2 % 12, row = T0 + tl, off = (which ? PR_AD : PR_WD) + ch * 8;
            const bool act = idx < 144 * 12 * 2 && tl < 130 && (SMP ? row >= NTOK_P : row < NTOK_P);
            const int srow = act ? row : T0;
            const bf16_t* pr = PROJ + (size_t)srow * LDP + C_PR + off; cur[k] = *(const u32x4*)pr;
            if (SMP) { const float* sh = p->in[I_SSH] + (size_t)(act ? row - NTOK_P : 0) * SHIFT_W + off; pf0[k] = *(const f32x4*)sh; pf1[k] = *(const f32x4*)(sh + 4); prv[k] = cur[k]; }
            else { const bool first = !act || (srow & (SEQ - 1)) == 0; prv[k] = *(const u32x4*)(first ? pr : pr - LDP); pf0[k] = (f32x4){0.f, 0.f, 0.f, 0.f}; pf1[k] = pf0[k]; } }
#pragma unroll
        for (int k = 0; k < 4; ++k) { const int idx = tid + (hb * 4 + k) * 512, which = idx >= 144 * 12, i2 = which ? idx - 144 * 12 : idx, tl = i2 / 12, ch = i2 % 12, row = T0 + tl, off = (which ? PR_AD : PR_WD) + ch * 8;
            const bool inr = idx < 144 * 12 * 2, act = inr && tl < 130 && (SMP ? row >= NTOK_P : row < NTOK_P);
            const f32x4 m0 = *(const f32x4*)(mu + off), m1 = *(const f32x4*)(mu + off + 4);
            float c[8], pv[8], f[8]; unpack8(cur[k], c);
            if (SMP) { pv[0] = pf0[k][0]; pv[1] = pf0[k][1]; pv[2] = pf0[k][2]; pv[3] = pf0[k][3]; pv[4] = pf1[k][0]; pv[5] = pf1[k][1]; pv[6] = pf1[k][2]; pv[7] = pf1[k][3]; }
            else { unpack8(prv[k], pv); const float keep = (row & (SEQ - 1)) == 0 ? 0.f : 1.f;
#pragma unroll
                for (int q = 0; q < 8; ++q) pv[q] *= keep; }
#pragma unroll
            for (int q = 0; q < 8; ++q) { const float x = c[q] + (q < 4 ? m0[q & 3] : m1[q & 3]) * (pv[q] - c[q]); f[q] = which ? x : tanh_fast(x); }
            const u32x4 o = act ? pack8(f) : (u32x4){0u, 0u, 0u, 0u};
            if (SMP ? act : (inr && (tl >= 130 || row < NTOK_P))) *(LAS u32x4*)((which ? Aa : Aw) + tl * 104 + ch * 8) = o; }
    }
}
__device__ void lora_tile(PP p, int tile, LAS unsigned char* lds) {
    const int tid = tid_opaque(), wid = tid >> 6, lane = tid & 63, fr = lane & 15, fq = lane >> 4, cs = tile & 3, T0 = (tile >> 2) * 130;
    const bf16_t* PROJ = (const bf16_t*)(p->ws + WS_PROJ); const float* mu = p->in[I_MU];
    LAS bf16_t* Aw = (LAS bf16_t*)lds; LAS bf16_t* Aa = Aw + 144 * 104;
    bf16x8 bfr[2][4][3]; f32x4 bias[2][4];
#pragma unroll
    for (int lo = 0; lo < 2; ++lo) { const bf16_t* Bt = (const bf16_t*)(p->ws + (lo ? WS_A2T : WS_W2T)); const float* b0 = p->in[lo ? I_A0 : I_W0];
#pragma unroll
        for (int nt = 0; nt < 4; ++nt) { const int base = cs * 512 + wid * 64 + (nt >> 1) * 32, n1 = nt & 1;
            bias[lo][nt] = *(const f32x4*)(b0 + base + 8 * fq + 4 * n1);
#pragma unroll
            for (int ks = 0; ks < 3; ++ks) bfr[lo][nt][ks] = *(const bf16x8*)(Bt + (size_t)(base + 8 * (fr >> 2) + 4 * n1 + (fr & 3)) * 96 + ks * 32 + fq * 8); } }
    lora_stage<false>(p, T0, tid, Aw, Aa);
    if (T0 + 130 > NTOK_P) lora_stage<true>(p, T0, tid, Aw, Aa);
    __syncthreads();
#pragma unroll 1
    for (int mt = 0; mt < 9; ++mt) { const int tl = mt * 16 + fr, row = T0 + tl; const bool ok = tl < 130;
#pragma unroll
        for (int lo = 0; lo < 2; ++lo) { const LAS bf16_t* A = lo ? Aa : Aw; bf16x8 af[3];
#pragma unroll
            for (int ks = 0; ks < 3; ++ks) af[ks] = *(const LAS bf16x8*)(A + tl * 104 + ks * 32 + fq * 8);
            bf16_t* op = lo ? (bf16_t*)(p->ws + WS_AAA) + (size_t)row * D : (row >= NTOK_P ? (bf16_t*)(p->ws + WS_ES) + (size_t)(row - NTOK_P) * D : (bf16_t*)(p->ws + WS_E) + (size_t)row * D);
            const float mul = lo ? 1.f : 0.6065306597126334f;
#pragma unroll
            for (int k2 = 0; k2 < 2; ++k2) { u32x4 o;
#pragma unroll
                for (int n1 = 0; n1 < 2; ++n1) { const int nt = k2 * 2 + n1; f32x4 acc = (f32x4){0.f, 0.f, 0.f, 0.f};
#pragma unroll
                    for (int ks = 0; ks < 3; ++ks) acc = __builtin_amdgcn_mfma_f32_16x16x32_bf16(bfr[lo][nt][ks], af[ks], acc, 0, 0, 0);
                    o[n1 * 2] = cvt_pk_bf16(sigmoid_f(acc[0] + bias[lo][nt][0]) * mul, sigmoid_f(acc[1] + bias[lo][nt][1]) * mul); o[n1 * 2 + 1] = cvt_pk_bf16(sigmoid_f(acc[2] + bias[lo][nt][2]) * mul, sigmoid_f(acc[3] + bias[lo][nt][3]) * mul); }
                if (ok) *(u32x4*)(op + cs * 512 + wid * 64 + k2 * 32 + 8 * fq) = o; } } }
    __syncthreads();
}
constexpr int T3_MIXA = 512, T3_MIXS = 16, T3_LORA = 256, T3_TOTAL = T3_MIXA + T3_MIXS + T3_LORA;
__device__ void phase3(PP p, LAS unsigned char* lds) {
    REP(11) for (int t = blockIdx.x; t < T3_MIXA + T3_MIXS; t += gridDim.x) {
        if (t < T3_MIXA) mixa_tile(p, t, lds);
        else mixa_sample_row(p, (t - T3_MIXA) * 8 + (tid_opaque() >> 6));
    }
    REP(12) for (int t = blockIdx.x; t < T3_LORA; t += gridDim.x) lora_tile(p, (t + 16) % T3_LORA, lds);
}

struct HeadPar { float mu_r, mu_k, mu_v, kk_s, ka, rk; };
__device__ __forceinline__ float head_vectors(const HeadPar& hp, float r_c, float k_c, float v_c, float r_p, float k_p, float v_p, float a, float e, LAS float* dst, int j, float& v_out) {
    const float r = r_c + hp.mu_r * (r_p - r_c), k = k_c + hp.mu_k * (k_p - k_c), v = v_c + hp.mu_v * (v_p - v_c);
    const float w = __expf(-e);
    float kk = k * hp.kk_s; const float n2 = wave_sum(kk * kk); kk = kk / fmaxf(sqrtf(n2), 1e-12f);
    const float kp = k * (1.f + (a - 1.f) * hp.ka), bb = kk * a;
    const float cc = wave_sum(r * kp * hp.rk);
    dst[j] = r; dst[64 + j] = w; dst[128 + j] = kp; dst[192 + j] = kk; dst[256 + j] = bb; dst[320 + j] = v; v_out = v;
    return cc;
}
struct SmpRegs { f32x4 S[16]; bf16_t r_c, k_c, v_c, e, a, zb; float r_p, k_p, v_p, gng, gnb; HeadPar hp; };
__device__ __forceinline__ void smp_load(PP p, int item, SmpRegs& R, int lane_) {
    int lane = lane_; asm volatile("" : "+v"(lane));
    const int bs = item >> 5, h = item & 31, hc = h * 64 + lane; const size_t row = NTOK_P + bs;
    const bf16_t* PROJ = (const bf16_t*)(p->ws + WS_PROJ);
    const bf16_t* pr = PROJ + row * LDP + C_PR + hc; const float* sh = p->in[I_SSH] + (size_t)bs * SHIFT_W + hc;
    R.r_c = pr[PR_R]; R.k_c = pr[PR_K]; R.v_c = pr[PR_V]; R.r_p = sh[PR_R]; R.k_p = sh[PR_K]; R.v_p = sh[PR_V];
    R.e = ((const bf16_t*)(p->ws + WS_ES))[(size_t)bs * D + hc]; R.a = ((const bf16_t*)(p->ws + WS_AAA))[row * D + hc]; R.zb = PROJ[row * LDP + C_ZB + hc];
    R.hp.mu_r = p->in[I_MU][PR_R + hc]; R.hp.mu_k = p->in[I_MU][PR_K + hc]; R.hp.mu_v = p->in[I_MU][PR_V + hc]; R.hp.kk_s = p->in[I_KK][hc]; R.hp.ka = p->in[I_KA][hc]; R.hp.rk = p->in[I_RK][hc];
    R.gng = p->in[I_GNG][hc]; R.gnb = p->in[I_GNB][hc];
    const float* s0 = p->in[I_SWKV] + ((size_t)(bs * 32 + h) * 64 + lane) * 64;
#pragma unroll
    for (int q = 0; q < 16; ++q) R.S[q] = *(const f32x4*)(s0 + q * 4);
}
__device__ __forceinline__ void smp_finish(PP p, int item, SmpRegs& R, LAS float* wl, int lane_) {
    int lane = lane_; asm volatile("" : "+v"(lane));
    const int bs = item >> 5, h = item & 31, hc = h * 64 + lane; const size_t row = NTOK_P + bs;
    float v; const float cc = head_vectors(R.hp, bf2f(R.r_c), bf2f(R.k_c), bf2f(R.v_c), R.r_p, R.k_p, R.v_p, bf2f(R.a), bf2f(R.e), wl, lane, v);
    __builtin_amdgcn_wave_barrier();
    float* s1 = p->out + O_WKVS + ((size_t)(bs * 32 + h) * 64 + lane) * 64;
    float sp = 0.f;
#pragma unroll
    for (int q = 0; q < 16; ++q) { const f32x4 kk = *(const LAS f32x4*)(wl + 192 + q * 4); sp += R.S[q][0] * kk[0] + R.S[q][1] * kk[1] + R.S[q][2] * kk[2] + R.S[q][3] * kk[3]; if ((q & 3) == 3) __builtin_amdgcn_sched_barrier(0); }
    const float sa = -sp; float y = 0.f;
#pragma unroll
    for (int q = 0; q < 16; ++q) { const f32x4 w = *(const LAS f32x4*)(wl + 64 + q * 4), bb = *(const LAS f32x4*)(wl + 256 + q * 4), kp = *(const LAS f32x4*)(wl + 128 + q * 4), r = *(const LAS f32x4*)(wl + q * 4);
        const f32x4 sn = R.S[q] * w + sa * bb + v * kp; y += sn[0] * r[0] + sn[1] * r[1] + sn[2] * r[2] + sn[3] * r[3]; *(f32x4*)(s1 + q * 4) = sn; if ((q & 1) == 1) __builtin_amdgcn_sched_barrier(0); }
    const float m = wave_sum(y) * (1.f / 64.f), d = y - m, var = wave_sum(d * d) * (1.f / 64.f);
    const float yn = d * rsqrtf(var + 64e-5f) * R.gng + R.gnb;
    ((bf16_t*)(p->ws + WS_YB))[row * D + hc] = f2bf((yn + cc * v) * bf2f(R.zb));
    __builtin_amdgcn_wave_barrier();
}
__device__ void scan_sample_item(PP p, int item, LAS float* wl) {
    const int lane = tid_opaque() & 63; SmpRegs R; smp_load(p, item, R, lane); smp_finish(p, item, R, wl, lane);
}
constexpr int BGC_PA = 32 * 32, BGC_PB = 64 * 32, BGC_WO = 64 * 32, BGC_TOTAL = BGC_PA + BGC_PB + BGC_WO, BGC_WAVES = 768;
struct BgcRegs { f32x4 r[8]; };
__device__ __forceinline__ void bgc_desc(PP p, int u, const float*& sp, bf16_t*& dp, int& K) {
    if (u < BGC_PA) { const int tk = u & 31, tn = u >> 5; K = A_W; sp = p->in[I_PA] + (size_t)tk * 32 * D + tn * 64; dp = (bf16_t*)(p->ws + WS_WTPA) + (size_t)tn * 64 * A_W + tk * 32; return; }
    u -= BGC_PA; K = D; const int tk = u & 63, tn = (u >> 6) & 31;
    if (u < BGC_PB) { sp = p->in[I_PB] + (size_t)tk * 32 * D + tn * 64; dp = (bf16_t*)(p->ws + WS_WTPB) + (size_t)tn * 64 * D + tk * 32; return; }
    sp = p->in[I_WOUT] + (size_t)tk * 32 * D + tn * 64; dp = (bf16_t*)(p->ws + WS_WTOUT) + (size_t)tn * 64 * D + tk * 32;
}
__device__ __forceinline__ void bgc_load(PP p, int u, BgcRegs& R, int lane_) {
    int lane = lane_; asm volatile("" : "+v"(lane));
    const float* sp; bf16_t* dp; int K; bgc_desc(p, u, sp, dp, K);
#pragma unroll
    for (int i = 0; i < 8; ++i) { const int idx = lane + 64 * i; R.r[i] = *(const f32x4*)(sp + (size_t)(idx >> 4) * D + (idx & 15) * 4); }
}
__device__ __forceinline__ void bgc_finish(PP p, int u, const BgcRegs& R, LAS float* t, int lane_) {
    int lane = lane_; asm volatile("" : "+v"(lane));
    const float* sp; bf16_t* dp; int K; bgc_desc(p, u, sp, dp, K);
#pragma unroll
    for (int i = 0; i < 8; ++i) { const int idx = lane + 64 * i, o = (idx >> 4) * 65 + (idx & 15) * 4; t[o] = R.r[i][0]; t[o + 1] = R.r[i][1]; t[o + 2] = R.r[i][2]; t[o + 3] = R.r[i][3]; }
    __builtin_amdgcn_wave_barrier();
#pragma unroll
    for (int i = 0; i < 4; ++i) { const int ch = lane + 64 * i, nl = ch >> 2, kc = ch & 3; float f[8];
#pragma unroll
        for (int j = 0; j < 8; ++j) f[j] = t[(kc * 8 + j) * 65 + nl];
        *(u32x4*)(dp + (size_t)nl * K + kc * 8) = pack8(f); }
    __builtin_amdgcn_wave_barrier();
}
constexpr int TS = 32, CHF = TS * 384, NCH = SEQ / TS;
__device__ __forceinline__ float red16(float x) { x += dppf<0xB1>(x); x += dppf<0x4E>(x); x += dppf<0x141>(x); x += dppf<0x140>(x); return x; }
struct LdRegs { u32x4 rc, kc, vc, rp, kp, vp, e, a; };
struct StepRegs { f32x4 r, w, k, q, b; f32x2 v;
    __device__ __forceinline__ void ld(const LAS float* L, int cq, int i0) { r = *(const LAS f32x4*)(L + cq); w = *(const LAS f32x4*)(L + 64 + cq); k = *(const LAS f32x4*)(L + 128 + cq); q = *(const LAS f32x4*)(L + 192 + cq); b = *(const LAS f32x4*)(L + 256 + cq); v = *(const LAS f32x2*)(L + 320 + i0); } };
__device__ void scan_prompt_item(PP p, int item, LAS float* lds) {
    const int tid = tid_opaque(), wid = __builtin_amdgcn_readfirstlane(tid >> 6), lane = tid & 63;
    const int b = item >> 6, h = (item >> 1) & 31, half = item & 1;
    const bf16_t* PROJ = (const bf16_t*)(p->ws + WS_PROJ);
    if (wid >= 4) {
        const int lw = wid - 4, sl = lw * 8 + (lane >> 3), ch0 = (lane & 7) * 8, hc_ = h * 64 + ch0;
        const bf16_t* E = (const bf16_t*)(p->ws + WS_E); const bf16_t* AAA = (const bf16_t*)(p->ws + WS_AAA); float* Cc = (float*)(p->ws + WS_C);
        const bool wr_c = (half == 0) && ((lane & 7) == 0);
        auto load = [&](int c, LdRegs& R) { int hc = hc_; asm volatile("" : "+v"(hc)); const int t = c * TS + sl; const size_t row = (size_t)b * SEQ + t; const bf16_t* pr = PROJ + row * LDP + C_PR + hc;
            R.rc = *(const u32x4*)(pr + PR_R); R.kc = *(const u32x4*)(pr + PR_K); R.vc = *(const u32x4*)(pr + PR_V);
            if (t > 0) { R.rp = *(const u32x4*)(pr + PR_R - LDP); R.kp = *(const u32x4*)(pr + PR_K - LDP); R.vp = *(const u32x4*)(pr + PR_V - LDP); }
            else { R.rp = (u32x4){0u, 0u, 0u, 0u}; R.kp = R.rp; R.vp = R.rp; }
            R.e = *(const u32x4*)(E + row * D + hc); R.a = *(const u32x4*)(AAA + row * D + hc); };
        auto process = [&](int c, const LdRegs& R) { int hc = hc_; asm volatile("" : "+v"(hc)); LAS float* dst = lds + (c & 1) * CHF + sl * 384 + ch0;
            float rc[8], kc[8], vc[8], rp[8], kp[8], vp[8], e[8], a[8], r[8], k[8], v[8], w[8], kk[8], kq[8], bb[8];
            float mu_r[8], mu_k[8], mu_v[8], kks[8], ka[8], rk[8];
            { const float* mb = p->in[I_MU] + hc; const f32x4 a0 = *(const f32x4*)(mb + PR_R), a1 = *(const f32x4*)(mb + PR_R + 4), b0 = *(const f32x4*)(mb + PR_K), b1 = *(const f32x4*)(mb + PR_K + 4), c0 = *(const f32x4*)(mb + PR_V), c1 = *(const f32x4*)(mb + PR_V + 4);
              const f32x4 d0 = *(const f32x4*)(p->in[I_KK] + hc), d1 = *(const f32x4*)(p->in[I_KK] + hc + 4), e0 = *(const f32x4*)(p->in[I_KA] + hc), e1 = *(const f32x4*)(p->in[I_KA] + hc + 4), f0 = *(const f32x4*)(p->in[I_RK] + hc), f1 = *(const f32x4*)(p->in[I_RK] + hc + 4);
#pragma unroll
              for (int q = 0; q < 4; ++q) { mu_r[q] = a0[q]; mu_r[4 + q] = a1[q]; mu_k[q] = b0[q]; mu_k[4 + q] = b1[q]; mu_v[q] = c0[q]; mu_v[4 + q] = c1[q]; kks[q] = d0[q]; kks[4 + q] = d1[q]; ka[q] = e0[q]; ka[4 + q] = e1[q]; rk[q] = f0[q]; rk[4 + q] = f1[q]; } }
            unpack8(R.rc, rc); unpack8(R.kc, kc); unpack8(R.vc, vc); unpack8(R.rp, rp); unpack8(R.kp, kp); unpack8(R.vp, vp); unpack8(R.e, e); unpack8(R.a, a);
            float n2 = 0.f, cc = 0.f;
#pragma unroll
            for (int q = 0; q < 8; ++q) { r[q] = rc[q] + mu_r[q] * (rp[q] - rc[q]); k[q] = kc[q] + mu_k[q] * (kp[q] - kc[q]); v[q] = vc[q] + mu_v[q] * (vp[q] - vc[q]);
                w[q] = __builtin_amdgcn_exp2f(-1.4426950408889634f * e[q]); kk[q] = k[q] * kks[q]; n2 += kk[q] * kk[q];
                kq[q] = k[q] * (1.f + (a[q] - 1.f) * ka[q]); cc += r[q] * kq[q] * rk[q]; }
            n2 = red8(n2); cc = red8(cc); const float inv = 1.f / fmaxf(sqrtf(n2), 1e-12f);
#pragma unroll
            for (int q = 0; q < 8; ++q) { kk[q] *= inv; bb[q] = kk[q] * a[q]; }
            *(LAS f32x4*)(dst) = (f32x4){r[0], r[1], r[2], r[3]}; *(LAS f32x4*)(dst + 4) = (f32x4){r[4], r[5], r[6], r[7]};
            *(LAS f32x4*)(dst + 64) = (f32x4){w[0], w[1], w[2], w[3]}; *(LAS f32x4*)(dst + 68) = (f32x4){w[4], w[5], w[6], w[7]};
            *(LAS f32x4*)(dst + 128) = (f32x4){kq[0], kq[1], kq[2], kq[3]}; *(LAS f32x4*)(dst + 132) = (f32x4){kq[4], kq[5], kq[6], kq[7]};
            *(LAS f32x4*)(dst + 192) = (f32x4){kk[0], kk[1], kk[2], kk[3]}; *(LAS f32x4*)(dst + 196) = (f32x4){kk[4], kk[5], kk[6], kk[7]};
            *(LAS f32x4*)(dst + 256) = (f32x4){bb[0], bb[1], bb[2], bb[3]}; *(LAS f32x4*)(dst + 260) = (f32x4){bb[4], bb[5], bb[6], bb[7]};
            *(LAS f32x4*)(dst + 320) = (f32x4){v[0], v[1], v[2], v[3]}; *(LAS f32x4*)(dst + 324) = (f32x4){v[4], v[5], v[6], v[7]};
            if (wr_c) Cc[((size_t)b * SEQ + c * TS + sl) * 32 + h] = cc; };
        const bool bg = (gridDim.x == 256); const int gidx = blockIdx.x * 4 + lw; LAS float* wl = lds + 2 * CHF + lw * 384;
        auto chunk_head = [&]() { asm volatile("s_waitcnt lgkmcnt(0)" ::: "memory");
            __builtin_amdgcn_s_barrier(); asm volatile("" ::: "memory"); };
        LdRegs R; load(0, R); process(0, R); load(1, R);
        auto chunk_tail = [&](int c) { if (c + 1 < NCH) { process(c + 1, R); if (c + 2 < NCH) load(c + 2, R); } };
        LAS float* tl = lds + 2 * CHF + 4 * 384 + (lw < 3 ? lw : 0) * (32 * 65);
        const int gw3 = blockIdx.x * 3 + lw;
        auto plain = [&](int ca, int cb) {
#pragma unroll 1
            for (int c = ca; c < cb; ++c) { chunk_head(); chunk_tail(c); } };
        auto conv_slot = [&](int c, int k) { const int u = gw3 + BGC_WAVES * k;
            if (bg && lw < 3 && u < BGC_TOTAL) { BgcRegs CR; bgc_load(p, u, CR, lane); chunk_head(); bgc_finish(p, u, CR, tl, lane); chunk_tail(c); }
            else { chunk_head(); chunk_tail(c); } };
#pragma unroll 1
        for (int seg = 0; seg < NCH / 16; ++seg) { const int c0 = seg * 16;
            plain(c0, c0 + 3);
            if (bg) { SmpRegs SR; const int item = gidx + 1024 * seg; smp_load(p, item, SR, lane); chunk_head(); smp_finish(p, item, SR, wl, lane); chunk_tail(c0 + 3); }
            else { chunk_head(); chunk_tail(c0 + 3); }
            plain(c0 + 4, c0 + 7);
            conv_slot(c0 + 7, seg * 2);
            plain(c0 + 8, c0 + 12);
            conv_slot(c0 + 12, seg * 2 + 1);
            plain(c0 + 13, c0 + 16);
        }
    } else {
        __builtin_amdgcn_s_setprio(3);
        const int rp = lane >> 4, cq = (lane & 15) * 4, i0 = half * 32 + wid * 8 + rp * 2;
        bf16_t* Y = (bf16_t*)(p->ws + WS_Y) + (size_t)b * SEQ * D + h * 64 + i0;
        f32x2 S0a = {0.f, 0.f}, S0b = {0.f, 0.f}, S1a = {0.f, 0.f}, S1b = {0.f, 0.f};
        const int lq = lane & 15;
        for (int c = 0; c < NCH; ++c) {
            __syncthreads();
            const LAS float* L = lds + (c & 1) * CHF;
            StepRegs nx; nx.ld(L, cq, i0);
#pragma unroll
            for (int g = 0; g < TS / 16; ++g) {
                float yk = 0.f;
#pragma unroll
                for (int s = 0; s < 16; ++s) {
                    const StepRegs cu = nx; L += 384;
                    if (s < 15 || g + 1 < TS / 16) nx.ld(L, cq, i0);
                    __builtin_amdgcn_sched_barrier(0x477);
                    const f32x4 r4 = cu.r, w4 = cu.w, k4 = cu.k, q4 = cu.q, b4 = cu.b; const f32x2 v2 = cu.v;
                    const f32x2 ra = {r4[0], r4[1]}, rb = {r4[2], r4[3]}, wa = {w4[0], w4[1]}, wb = {w4[2], w4[3]}, ka_ = {k4[0], k4[1]}, kb = {k4[2], k4[3]}, qa = {q4[0], q4[1]}, qb = {q4[2], q4[3]}, ba = {b4[0], b4[1]}, bb_ = {b4[2], b4[3]};
                    f32x2 t0 = __builtin_elementwise_fma(S0b, qb, S0a * qa), t1 = __builtin_elementwise_fma(S1b, qb, S1a * qa);
                    const float sa0 = -red16(t0[0] + t0[1]), sa1 = -red16(t1[0] + t1[1]);
                    const f32x2 sa0v = {sa0, sa0}, sa1v = {sa1, sa1}, v0v = {v2[0], v2[0]}, v1v = {v2[1], v2[1]};
                    S0a = __builtin_elementwise_fma(S0a, wa, __builtin_elementwise_fma(sa0v, ba, v0v * ka_)); S0b = __builtin_elementwise_fma(S0b, wb, __builtin_elementwise_fma(sa0v, bb_, v0v * kb));
                    S1a = __builtin_elementwise_fma(S1a, wa, __builtin_elementwise_fma(sa1v, ba, v1v * ka_)); S1b = __builtin_elementwise_fma(S1b, wb, __builtin_elementwise_fma(sa1v, bb_, v1v * kb));
                    t0 = __builtin_elementwise_fma(S0b, rb, S0a * ra); t1 = __builtin_elementwise_fma(S1b, rb, S1a * ra);
                    const float x0 = t0[0] + t0[1], x1 = t1[0] + t1[1];
                    const bool odd = lane & 1; float u = odd ? x1 : x0; const float vv = odd ? x0 : x1;
                    u += dppf<0xB1>(vv); u += dppf<0x4E>(u); u += dppf<0x124>(u); u += dppf<0x128>(u);
                    yk = ((lq >> 1) == (s & 7)) ? u : yk;
                    if ((s & 7) == 7) Y[(size_t)(c * TS + g * 16 + (s - 7) + (lq >> 1)) * D + (lq & 1)] = f2bf(yk);
                }
            }
        }
        __builtin_amdgcn_s_setprio(0);
        float* so = p->out + O_WKVP + ((size_t)(b * 32 + h) * 64 + i0) * 64 + cq;
        *(f32x4*)so = (f32x4){S0a[0], S0a[1], S0b[0], S0b[1]}; *(f32x4*)(so + 64) = (f32x4){S1a[0], S1a[1], S1b[0], S1b[1]};
    }
    __syncthreads();
}
__device__ void phase4(PP p, LAS unsigned char* lds) {
    REP(4) for (int it = blockIdx.x; it < 256; it += gridDim.x) scan_prompt_item(p, it, (LAS float*)lds);
    const int wid = __builtin_amdgcn_readfirstlane(tid_opaque() >> 6);
    if (gridDim.x != 256) for (int it = blockIdx.x * 8 + wid; it < 4096; it += gridDim.x * 8) scan_sample_item(p, it, (LAS float*)lds + wid * 384);
}

__device__ void phase5(PP p) {
    const int tid = tid_opaque(), lane = tid & 63, gw = blockIdx.x * 8 + (tid >> 6), nw = gridDim.x * 8;
    const bf16_t* PROJ = (const bf16_t*)(p->ws + WS_PROJ); const bf16_t* Y = (const bf16_t*)(p->ws + WS_Y); const float* Cc = (const float*)(p->ws + WS_C); bf16_t* YB = (bf16_t*)(p->ws + WS_YB);
    f32x4 pmu[4][2], pg[4][2], pb[4][2];
#pragma unroll
    for (int q = 0; q < 4; ++q) { const int c0 = q * 512 + lane * 8;
#pragma unroll
        for (int hh = 0; hh < 2; ++hh) { pmu[q][hh] = *(const f32x4*)(p->in[I_MU] + PR_V + c0 + hh * 4); pg[q][hh] = *(const f32x4*)(p->in[I_GNG] + c0 + hh * 4); pb[q][hh] = *(const f32x4*)(p->in[I_GNB] + c0 + hh * 4); } }
    for (int row = gw; row < NTOK_P; row += nw) { const bool first = (row & (SEQ - 1)) == 0; const bf16_t* pr = PROJ + (size_t)row * LDP;
        u32x4 yr[4], vcr[4], vpr[4], zbr[4]; float ccs[4];
#pragma unroll
        for (int q = 0; q < 4; ++q) { const int c0 = q * 512 + lane * 8;
            yr[q] = *(const u32x4*)(Y + (size_t)row * D + c0);
            vcr[q] = *(const u32x4*)(pr + C_PR + PR_V + c0); vpr[q] = first ? (u32x4){0u, 0u, 0u, 0u} : *(const u32x4*)(pr - LDP + C_PR + PR_V + c0);
            zbr[q] = *(const u32x4*)(pr + C_ZB + c0); ccs[q] = Cc[(size_t)row * 32 + (c0 >> 6)]; }
#pragma unroll
        for (int q = 0; q < 4; ++q) { const int c0 = q * 512 + lane * 8; float y[8], vc[8], vp[8], zb[8], f[8];
            unpack8(yr[q], y);
            float s = 0.f;
#pragma unroll
            for (int k = 0; k < 8; ++k) s += y[k];
            const float m = red8(s) * (1.f / 64.f); float s2 = 0.f;
#pragma unroll
            for (int k = 0; k < 8; ++k) { y[k] -= m; s2 += y[k] * y[k]; }
            const float rstd = rsqrtf(red8(s2) * (1.f / 64.f) + 64e-5f);
            unpack8(vcr[q], vc); unpack8(vpr[q], vp); unpack8(zbr[q], zb);
#pragma unroll
            for (int k = 0; k < 8; ++k) { const float v = vc[k] + pmu[q][k >> 2][k & 3] * (vp[k] - vc[k]);
                f[k] = (y[k] * rstd * pg[q][k >> 2][k & 3] + pb[q][k >> 2][k & 3] + ccs[q] * v) * zb[k]; }
            *(u32x4*)(YB + (size_t)row * D + c0) = pack8(f); } }
    for (int idx = blockIdx.x * 512 + tid; idx < NMODROW * SHIFT_W; idx += gridDim.x * 512) { const int rr = idx / SHIFT_W, k = idx % SHIFT_W;
        const size_t srow = rr < 4 ? (size_t)rr * SEQ + SEQ - 1 : (size_t)NTOK_P + rr - 4;
        const float v = bf2f(PROJ[srow * LDP + C_PR + k]);
        if (rr < 4) p->out[O_SHP + (size_t)rr * SHIFT_W + k] = v; else p->out[O_SHS + (size_t)(rr - 4) * SHIFT_W + k] = v; }
}

__device__ void phase9(PP p) {
    const int tid = tid_opaque(), lane = tid & 63, gw = blockIdx.x * 8 + (tid >> 6), nw = gridDim.x * 8; const float* fg = p->in[I_FG];
    const bf16_t* OB = (const bf16_t*)(p->ws + WS_Y);
    f32x4 g[4][2]; u32x4 v[4], vn[4];
#pragma unroll
    for (int i = 0; i < 4; ++i) { g[i][0] = *(const f32x4*)(fg + (lane + 64 * i) * 8); g[i][1] = *(const f32x4*)(fg + (lane + 64 * i) * 8 + 4); }
    if (gw < NTOK) {
#pragma unroll
        for (int i = 0; i < 4; ++i) v[i] = *(const u32x4*)(OB + (size_t)gw * D + (lane + 64 * i) * 8); }
    for (int r = gw; r < NTOK; r += nw) { float* o = p->out + O_Y + (size_t)r * D; const int rn = r + nw;
        if (rn < NTOK) {
#pragma unroll
            for (int i = 0; i < 4; ++i) vn[i] = *(const u32x4*)(OB + (size_t)rn * D + (lane + 64 * i) * 8); }
        float f[4][8]; float ss = 0.f;
#pragma unroll
        for (int i = 0; i < 4; ++i) { unpack8(v[i], f[i]);
#pragma unroll
            for (int q = 0; q < 8; ++q) ss += f[i][q] * f[i][q]; }
        ss = wave_sum(ss); const float rstd = rsqrtf(ss * (1.f / D) + 1e-6f);
#pragma unroll
        for (int i = 0; i < 4; ++i) { const int c = (lane + 64 * i) * 8;
            *(f32x4*)(o + c) = (f32x4){f[i][0], f[i][1], f[i][2], f[i][3]} * rstd * g[i][0]; *(f32x4*)(o + c + 4) = (f32x4){f[i][4], f[i][5], f[i][6], f[i][7]} * rstd * g[i][1]; }
#pragma unroll
        for (int i = 0; i < 4; ++i) v[i] = vn[i];
    }
}

#ifndef DBG_STOP
#define DBG_STOP 99
#endif
__device__ void dbg_dump(PP p) {
    const size_t n = O_CV + 128 * 1024, gt = (size_t)blockIdx.x * 512 + tid_opaque(), gs = (size_t)gridDim.x * 512;
    const bf16_t* w = (const bf16_t*)p->ws;
    for (size_t i = gt; i < n; i += gs) {
        float a = 0.f;
        if (DBG_STOP == 2) { const bf16_t* q = w + WS_PROJ / 2; for (int k = 0; k < 3; ++k) a += bf2f(q[i + (size_t)k * n]); }
        if (DBG_STOP == 1) { const bf16_t* q = w + WS_H / 2; a = bf2f(q[i % ((size_t)MP * D)]); }
        if (DBG_STOP == 0) { const bf16_t* q = w + WS_WTIN / 2; a = bf2f(q[i % ((size_t)LDP * D)]) + bf2f(q[(i + n) % ((size_t)LDP * D)]) + ((const float*)(p->ws + WS_MOD))[i % (NMODROW * 6144)]; }
        if (DBG_STOP == 3) { a = bf2f(w[WS_E / 2 + i % ((size_t)NTOK * D)]) + bf2f(w[WS_AAA / 2 + i % ((size_t)NTOK * D)]) + bf2f(w[WS_YA / 2 + i % ((size_t)NTOK * A_W)]); }
        if (DBG_STOP == 4) { a = bf2f(((const bf16_t*)(p->ws + WS_Y))[i % ((size_t)NTOK_P * D)]) + ((const float*)(p->ws + WS_C))[i % (NTOK_P * 32)]; if (i >= O_WKVP) continue; }
        if (DBG_STOP == 5) { a = bf2f(w[WS_YB / 2 + i % ((size_t)NTOK * D)]); if (i >= O_WKVP) continue; }
        if (DBG_STOP == 7) { a = bf2f(w[WS_MRG / 2 + i % ((size_t)NTOK * D)]); if (i >= O_WKVP) continue; }
        p->out[i] = a;
    }
}

constexpr int NPHASE = 10, LDS_BYTES = 131072 + 16;
__global__ void __launch_bounds__(512) mega(P p_) {
    extern __shared__ __attribute__((aligned(16))) unsigned char shm[];
    LAS unsigned char* lds = (LAS unsigned char*)shm;
    PP p0 = (PP)__builtin_amdgcn_kernarg_segment_ptr();
    const int ph_lo = p0->ph_lo, ph_hi = p0->ph_hi;
    volatile LAS unsigned* st = (volatile LAS unsigned*)(lds + 131072);
    if (threadIdx.x == 0) { st[0] = 0u; st[1] = 0u; st[2] = 0u; st[3] = 0u; }
    __syncthreads();
    const XcdBarrier xb = xcd_barrier_post((unsigned*)(p0->ws + WS_BAR), st);
#ifndef PH_MASK
#define PH_MASK 0x3ff
#endif
#define GSYNC() xcd_barrier(xb)
#define PHASE(n) if (((PH_MASK >> (n)) & 1) && (n) <= DBG_STOP && ph_lo <= (n) && (n) < ph_hi) { if ((n) > ph_lo) GSYNC(); PP p = p0; asm volatile("" : "+s"(p));
#define PHASE_NOSYNC(n) if (((PH_MASK >> (n)) & 1) && (n) <= DBG_STOP && ph_lo <= (n) && (n) < ph_hi) { PP p = p0; asm volatile("" : "+s"(p));
#define PHASE_END }
    PHASE(0) REP(0) { phase0(p, lds); __syncthreads(); } PHASE_END
    PHASE(1) REP(1) phase1(p); PHASE_END
    PHASE(2) REP(2) { pg8::Gemm g{(const bf16_t*)(p->ws + WS_H), (const bf16_t*)(p->ws + WS_WTIN), MP, LDP, D}; pg8::StaticOrder S; S.init(MP, LDP, gridDim.x, blockIdx.x);
        EpiProj E{(bf16_t*)(p->ws + WS_PROJ)}; pg8::gemm_phase(lds, g, S, E); } PHASE_END
#ifdef EXTRA_SYNCS
    for (int i_ = 0; i_ < EXTRA_SYNCS; ++i_) GSYNC();
#endif
    PHASE(3) REP(3) { phase3(p, lds); __syncthreads(); } PHASE_END
    PHASE(4) phase4(p, lds); PHASE_END
    PHASE(5) REP(5) phase5(p); PHASE_END
    PHASE(6) REP(6) { pg8::Gemm g{(const bf16_t*)(p->ws + WS_YA), (const bf16_t*)(p->ws + WS_WTPA), NTOK_P, D, A_W}; pg8::StaticOrder S; S.init(NTOK_P, D, gridDim.x, blockIdx.x);
        EpiMerge<false> E{(bf16_t*)(p->ws + WS_MRG), (const bf16_t*)(p->ws + WS_PROJ) + C_GA}; pg8::gemm_phase(lds, g, S, E);
        bf16_t* mrg = (bf16_t*)(p->ws + WS_MRG) + (size_t)NTOK_P * D; const bf16_t* gp = (const bf16_t*)(p->ws + WS_PROJ) + (size_t)NTOK_P * LDP + C_GA;
        small_gemm((const bf16_t*)(p->ws + WS_YA) + (size_t)NTOK_P * A_W, (const bf16_t*)(p->ws + WS_WTPA), A_W, (LAS float*)lds, [&](const f32x4 acc, int r, int c) {
            const u32x2 g2 = *(const u32x2*)(gp + (size_t)r * LDP + c); u32x2 o; o[0] = cvt_pk_bf16(acc[0] * bflo(g2[0]), acc[1] * bfhi(g2[0])); o[1] = cvt_pk_bf16(acc[2] * bflo(g2[1]), acc[3] * bfhi(g2[1]));
            *(u32x2*)(mrg + (size_t)r * D + c) = o; }); } PHASE_END
    PHASE_NOSYNC(7) { pg8::Gemm g{(const bf16_t*)(p->ws + WS_YB), (const bf16_t*)(p->ws + WS_WTPB), NTOK_P, D, B_W}; pg8::StaticOrder S; S.init(NTOK_P, D, gridDim.x, blockIdx.x);
        EpiMerge<true> E{(bf16_t*)(p->ws + WS_MRG), (const bf16_t*)(p->ws + WS_PROJ) + C_GB}; pg8::gemm_phase(lds, g, S, E);
        bf16_t* mrg = (bf16_t*)(p->ws + WS_MRG) + (size_t)NTOK_P * D; const bf16_t* gp = (const bf16_t*)(p->ws + WS_PROJ) + (size_t)NTOK_P * LDP + C_GB;
        small_gemm((const bf16_t*)(p->ws + WS_YB) + (size_t)NTOK_P * B_W, (const bf16_t*)(p->ws + WS_WTPB), B_W, (LAS float*)lds, [&](const f32x4 acc, int r, int c) {
            const u32x2 g2 = *(const u32x2*)(gp + (size_t)r * LDP + c), m2 = *(const u32x2*)(mrg + (size_t)r * D + c); u32x2 o;
            o[0] = cvt_pk_bf16(bflo(m2[0]) + acc[0] * bflo(g2[0]), bfhi(m2[0]) + acc[1] * bfhi(g2[0])); o[1] = cvt_pk_bf16(bflo(m2[1]) + acc[2] * bflo(g2[1]), bfhi(m2[1]) + acc[3] * bfhi(g2[1]));
            *(u32x2*)(mrg + (size_t)r * D + c) = o; }); } PHASE_END
    PHASE(8) REP(8) { pg8::Gemm g{(const bf16_t*)(p->ws + WS_MRG), (const bf16_t*)(p->ws + WS_WTOUT), NTOK_P, D, D}; pg8::StaticOrder S; S.init(NTOK_P, D, gridDim.x, blockIdx.x);
        EpiOut E{(bf16_t*)(p->ws + WS_Y), p->in[I_XP], p->in[I_XS], (const float*)(p->ws + WS_MOD)}; pg8::gemm_phase(lds, g, S, E);
        bf16_t* os = (bf16_t*)(p->ws + WS_Y) + (size_t)NTOK_P * D; const float* xs = p->in[I_XS]; const float* gate = (const float*)(p->ws + WS_MOD) + (size_t)4 * 6144 + 4096;
        small_gemm((const bf16_t*)(p->ws + WS_MRG) + (size_t)NTOK_P * D, (const bf16_t*)(p->ws + WS_WTOUT), D, (LAS float*)lds, [&](const f32x4 acc, int r, int c) {
            const f32x4 o = *(const f32x4*)(xs + (size_t)r * D + c) + *(const f32x4*)(gate + (size_t)r * 6144 + c) * acc; u32x2 ob; ob[0] = cvt_pk_bf16(o[0], o[1]); ob[1] = cvt_pk_bf16(o[2], o[3]);
            *(u32x2*)(os + (size_t)r * D + c) = ob; }); } PHASE_END
    PHASE(9) phase9(p); PHASE_END
    if (DBG_STOP < 9) { GSYNC(); PP p = p0; asm volatile("" : "+s"(p)); dbg_dump(p); }
}

extern "C" void kernel_launch(void* const* d_in, const int* in_sizes, int n_in, void* d_out, int out_size, void* d_ws, size_t ws_size, hipStream_t stream) {
    static int grid_blocks = 0;
    if (grid_blocks == 0) {
        if (n_in != 28 || ws_size < WS_END) { fprintf(stderr, "kernel_launch: unexpected n_in %d or ws_size %zu (need %zu)\n", n_in, ws_size, (size_t)WS_END); grid_blocks = -1; return; }
        int dev = 0, cus = 0, per_cu = 0;
        (void)hipGetDevice(&dev);
        (void)hipDeviceGetAttribute(&cus, hipDeviceAttributeMultiprocessorCount, dev);
        if (hipFuncSetAttribute((const void*)mega, hipFuncAttributeMaxDynamicSharedMemorySize, LDS_BYTES) != hipSuccess) { fprintf(stderr, "kernel_launch: hipFuncSetAttribute failed\n"); grid_blocks = -1; return; }
        if (hipOccupancyMaxActiveBlocksPerMultiprocessor(&per_cu, (const void*)mega, 512, LDS_BYTES) != hipSuccess || per_cu < 1) { fprintf(stderr, "kernel_launch: occupancy query failed (%d)\n", per_cu); grid_blocks = -1; return; }
        grid_blocks = cus * per_cu;
    }
    if (grid_blocks < 0) return;
    if (hipMemsetAsync((unsigned char*)d_ws + WS_BAR, 0, XCD_BAR_WORDS_C * 4, stream) != hipSuccess) { fprintf(stderr, "kernel_launch: memset of barrier words failed\n"); return; }
    P p{};
    for (int i = 0; i < 28; ++i) p.in[i] = (const float*)d_in[i];
    p.out = (float*)d_out; p.ws = (unsigned char*)d_ws;
#if N_LAUNCH_PER_PHASE
    for (int ph = 0; ph < NPHASE; ++ph) { p.ph_lo = ph; p.ph_hi = ph + 1; void* args[] = {&p};
        hipError_t e = hipLaunchCooperativeKernel((const void*)mega, dim3(grid_blocks), dim3(512), args, LDS_BYTES, stream);
        if (e != hipSuccess) { fprintf(stderr, "cooperative launch failed: %s (grid %d)\n", hipGetErrorString(e), grid_blocks); return; } }
#else
    p.ph_lo = 0; p.ph_hi = NPHASE; void* args[] = {&p};
    hipError_t e = hipLaunchCooperativeKernel((const void*)mega, dim3(grid_blocks), dim3(512), args, LDS_BYTES, stream);
    if (e != hipSuccess) fprintf(stderr, "cooperative launch failed: %s (grid %d)\n", hipGetErrorString(e), grid_blocks);
#endif
}
```

```cpp
#include <hip/hip_runtime.h>
#include <cstdio>

#ifndef REP_MASK
#define REP_MASK 0
#endif
#define REP(n) for (int rep_ = 0; rep_ < (((REP_MASK >> (n)) & 1) ? 2 : 1); ++rep_)
#ifndef N_LAUNCH_PER_PHASE
#define N_LAUNCH_PER_PHASE 0
#endif

#define LAS __attribute__((address_space(3)))
typedef unsigned short bf16_t;
typedef short bf16x8 __attribute__((ext_vector_type(8)));
typedef float f32x4 __attribute__((ext_vector_type(4)));
typedef float f32x2 __attribute__((ext_vector_type(2)));
typedef unsigned u32x4 __attribute__((ext_vector_type(4)));
typedef unsigned u32x2 __attribute__((ext_vector_type(2)));

constexpr int D = 2048, NTOK_P = 8192, NTOK_S = 128, NTOK = 8320, MP = 8448, SEQ = 2048;
constexpr int A_W = 1024, B_W = 2048, SHIFT_W = 6336, IN_W = 15552;
constexpr int LDP = 15616;
constexpr int C_UA = 0, C_VA = 1024, C_ZA = 2048, C_PR = 3072, C_ZB = 9472, C_GA = 11520, C_GB = 13568;
constexpr int PR_R = 0, PR_WD = 2048, PR_K = 2144, PR_V = 4192, PR_AD = 6240;
constexpr int NMODROW = 132, XCD_BAR_WORDS_C = 3456;

constexpr size_t SZ_WTIN = (size_t)LDP * D * 2, SZ_H = (size_t)MP * D * 2;
constexpr size_t WS_WTIN = 0, WS_H = WS_WTIN + SZ_WTIN;
constexpr size_t WS_E = 0, WS_AAA = WS_E + (size_t)NTOK * D * 2, WS_YA = WS_AAA + (size_t)NTOK * D * 2, WS_YB = 0;
constexpr size_t WS_PROJ = WS_H + SZ_H, SZ_PROJ = (size_t)MP * LDP * 2;
constexpr size_t WS_WTPA = WS_PROJ + SZ_PROJ, WS_WTPB = WS_WTPA + (size_t)D * A_W * 2, WS_WTOUT = WS_WTPB + (size_t)D * B_W * 2;
constexpr size_t WS_W2T = WS_WTOUT + (size_t)D * D * 2, WS_A2T = WS_W2T + (size_t)B_W * 96 * 2;
constexpr size_t WS_MOD = WS_A2T + (size_t)B_W * 96 * 2, WS_C = WS_MOD + (size_t)NMODROW * 6144 * 4;
constexpr size_t WS_Y = WS_C + (size_t)NTOK_P * 32 * 4, WS_MRG = WS_Y + (size_t)NTOK_P * D * 4, WS_ES = WS_MRG + SZ_H, WS_BAR = WS_ES + (size_t)NTOK_S * D * 2, WS_END = WS_BAR + XCD_BAR_WORDS_C * 4;
static_assert(WS_YA + (size_t)MP * A_W * 2 <= WS_PROJ, "alias region overflow");

constexpr size_t O_Y = 0, O_WKVP = (size_t)NTOK * D, O_SHP = O_WKVP + 4 * 32 * 4096, O_WKVS = O_SHP + 4 * SHIFT_W, O_SHS = O_WKVS + (size_t)128 * 32 * 4096,
                 O_CV = O_SHS + (size_t)128 * SHIFT_W;

struct P {
    const float* in[28];
    float* out;
    unsigned char* ws;
    int ph_lo, ph_hi;
};
typedef const __attribute__((address_space(4))) P* PP;
enum { I_XP = 0, I_XS, I_CP, I_CS, I_SWKV, I_SSH, I_NORMG, I_WC, I_BC, I_WIN, I_LNG, I_LNB, I_WS, I_BS, I_MU, I_W0, I_W2, I_A0, I_A2, I_KK, I_KA, I_RK, I_GNG, I_GNB,
       I_PA, I_PB, I_WOUT, I_FG };

typedef __bf16 bf16x2_t __attribute__((ext_vector_type(2)));
__device__ __forceinline__ unsigned cvt_pk_bf16(float lo, float hi) { const f32x2 v = {lo, hi}; const bf16x2_t b = __builtin_convertvector(v, bf16x2_t); return __builtin_bit_cast(unsigned, b); }
__device__ __forceinline__ bf16_t f2bf(float f) { return (bf16_t)(cvt_pk_bf16(f, 0.f) & 0xffffu); }
__device__ __forceinline__ float bf2f(bf16_t b) { return __uint_as_float(((unsigned)b) << 16); }
__device__ __forceinline__ float bflo(unsigned u) { return __uint_as_float(u << 16); }
__device__ __forceinline__ float bfhi(unsigned u) { return __uint_as_float(u & 0xffff0000u); }
__device__ __forceinline__ int tid_opaque() { int t = threadIdx.x; asm volatile("" : "+v"(t)); return t; }
template <int CTRL> __device__ __forceinline__ float dppf(float x) { return __int_as_float(__builtin_amdgcn_update_dpp(0, __float_as_int(x), CTRL, 0xf, 0xf, false)); }
__device__ __forceinline__ float red8(float x) { x += dppf<0xB1>(x); x += dppf<0x4E>(x); x += dppf<0x141>(x); return x; }
__device__ __forceinline__ float wave_sum(float v) {
    v += dppf<0xB1>(v); v += dppf<0x4E>(v); v += dppf<0x141>(v); v += dppf<0x140>(v);
    const int iv = __float_as_int(v);
    return (__int_as_float(__builtin_amdgcn_readlane(iv, 0)) + __int_as_float(__builtin_amdgcn_readlane(iv, 16))) + (__int_as_float(__builtin_amdgcn_readlane(iv, 32)) + __int_as_float(__builtin_amdgcn_readlane(iv, 48)));
}
__device__ __forceinline__ float sigmoid_f(float x) { return __builtin_amdgcn_rcpf(1.f + __builtin_amdgcn_exp2f(-1.4426950408889634f * x)); }
__device__ __forceinline__ float tanh_fast(float x) { return 1.f - 2.f * __builtin_amdgcn_rcpf(1.f + __builtin_amdgcn_exp2f(2.8853900817779268f * x)); }
__device__ __forceinline__ float gelu_tanh_f(float x) { return x * sigmoid_f(1.5957691216057308f * (x + 0.044715f * x * x * x)); }
__device__ __forceinline__ float silu_f(float x) { return x * sigmoid_f(x); }
__device__ __forceinline__ void unpack8(const u32x4 r, float (&f)[8]) {
    f[0] = bflo(r[0]); f[1] = bfhi(r[0]); f[2] = bflo(r[1]); f[3] = bfhi(r[1]); f[4] = bflo(r[2]); f[5] = bfhi(r[2]); f[6] = bflo(r[3]); f[7] = bfhi(r[3]);
}
__device__ __forceinline__ u32x4 pack8(const float (&f)[8]) { u32x4 r; r[0] = cvt_pk_bf16(f[0], f[1]); r[1] = cvt_pk_bf16(f[2], f[3]); r[2] = cvt_pk_bf16(f[4], f[5]); r[3] = cvt_pk_bf16(f[6], f[7]); return r; }


#define XB_TMO      128
#define XB_XCNT(j)  (256  + 64 * (j))
#define XB_XSUB(j)  (1280 + 64 * (j))
#define XB_XGEN(j)  (2304 + 64 * (j))
#define XB_TOP      3328
#define XB_TOPGEN   3392
#define XCD_BAR_WORDS 3456
#define XB_SPIN_CAP (1u << 18)
__device__ __forceinline__ unsigned xb_ld(unsigned* p)              { return __hip_atomic_load(p, __ATOMIC_RELAXED, __HIP_MEMORY_SCOPE_AGENT); }
__device__ __forceinline__ unsigned xb_add(unsigned* p, unsigned v) { return __hip_atomic_fetch_add(p, v, __ATOMIC_RELAXED, __HIP_MEMORY_SCOPE_AGENT); }
__device__ __forceinline__ unsigned xb_xcc_id() { return (unsigned)__builtin_amdgcn_s_getreg((3 << 11) | 20) & 0xFu; }
#define XB_SPIN(cond, bar) do { unsigned _sp = 0; while (cond) { __builtin_amdgcn_s_sleep(1); \
    if ((++_sp & 255u) == 0u) { if (xb_ld(&(bar)[XB_TMO])) break; if (_sp > XB_SPIN_CAP) { atomicAdd(&(bar)[XB_TMO], 1u); break; } } } } while (0)
struct XcdBarrier { unsigned* bar; unsigned x; volatile LAS unsigned* st; };
__device__ __forceinline__ XcdBarrier xcd_barrier_post(unsigned* bar, volatile LAS unsigned* st) {
    XcdBarrier b; b.bar = bar; b.x = xb_xcc_id(); b.st = st;
    if (threadIdx.x == 0) (void)xb_add(&bar[XB_XCNT(b.x)], 1u);
    return b;
}
__device__ __forceinline__ void xcd_barrier_complete(unsigned* bar, unsigned x, unsigned& nloc, unsigned& nx) {
    const unsigned G = gridDim.x * gridDim.y * gridDim.z;
    unsigned sum, cnt, mine, sp = 0u;
    for (;;) {
        sum = 0u; cnt = 0u; mine = 0u;
#pragma unroll
        for (unsigned j = 0; j < 16; ++j) { const unsigned c = xb_ld(&bar[XB_XCNT(j)]); sum += c; cnt += (c > 0u) ? 1u : 0u; mine = (j == x) ? c : mine; }
        if (sum == G) break;
        __builtin_amdgcn_s_sleep(1);
        if ((++sp & 255u) == 0u) { if (xb_ld(&bar[XB_TMO])) break; if (sp > XB_SPIN_CAP) { atomicAdd(&bar[XB_TMO], 1u); break; } }
    }
    nloc = mine > 0u ? mine : 1u; nx = cnt > 0u ? cnt : 1u;
}
__device__ __forceinline__ void xcd_barrier(const XcdBarrier& b) {
    asm volatile("s_waitcnt vmcnt(0)" ::: "memory");
    __syncthreads();
    if (threadIdx.x == 0) {
        unsigned* bar = b.bar;
        __builtin_amdgcn_s_waitcnt(0);
        unsigned nloc = b.st[0], nx = b.st[1];
        if (nloc == 0u) { xcd_barrier_complete(bar, b.x, nloc, nx); b.st[0] = nloc; b.st[1] = nx; }
        const unsigned old = xb_add(&bar[XB_XSUB(b.x)], 1u);
        const unsigned gen = old / nloc;
        if (old + 1u == (gen + 1u) * nloc) {
            __builtin_amdgcn_fence(__ATOMIC_RELEASE, "agent");
            asm volatile("s_waitcnt vmcnt(0)" ::: "memory");
            const unsigned og = xb_add(&bar[XB_TOP], 1u);
            const unsigned tg = og / nx;
            if (og + 1u == (tg + 1u) * nx) xb_add(&bar[XB_TOPGEN], 1u);
            else XB_SPIN(xb_ld(&bar[XB_TOPGEN]) == tg, bar);
            __builtin_amdgcn_fence(__ATOMIC_ACQUIRE, "agent");
            xb_add(&bar[XB_XGEN(b.x)], 1u);
            asm volatile("s_waitcnt vmcnt(0)" ::: "memory");
        } else {
            XB_SPIN(xb_ld(&bar[XB_XGEN(b.x)]) == gen, bar);
            __builtin_amdgcn_fence(__ATOMIC_ACQUIRE, "agent");
            asm volatile("s_waitcnt vmcnt(0)" ::: "memory");
        }
    }
    __syncthreads();
}

namespace pg8 {
constexpr int BM = 256, BK = 64, HALF = 128, HTB = HALF * BK * 2, STAGE_BYTES = 8 * HTB, NXCD = 8, WGM = 2;
__device__ __forceinline__ int lds_byte(int r, int c) { const int st = (r >> 4) * 2 + (c >> 5), rr = r & 15, cc = c & 31, ob = rr * 64 + cc * 2; return st * 1024 + (ob ^ (((ob >> 9) & 1) << 5)); }
__device__ __forceinline__ void stage_rc(int b, int& R, int& C) { const int st = b / 1024, sb = b % 1024, swz = sb ^ (((sb >> 9) & 1) << 5); R = (st >> 1) * 16 + swz / 64; C = (st & 1) * 32 + (swz % 64) / 2; }
__device__ __forceinline__ int perm32(int rho) { const int n = rho >> 4, i = rho & 15; return 8 * (i >> 2) + 4 * n + (i & 3); }
struct Unit { int pm, pn; };
struct Gemm { const bf16_t* A; const bf16_t* Bt; int M, N, K; };
struct StaticOrder {
    int nM, nN, nwg, G, c;
    __device__ void init(int M, int N, int G_, int c_) { nM = M / BM; nN = N / BM; nwg = nM * nN; G = G_; c = c_; }
    __device__ bool next(int i, Unit& u) const {
        const long L = (long)i * G + c; if (L >= nwg) return false;
        int wgid = (int)L; { const int q = nwg / NXCD, r = nwg % NXCD, xcd = wgid % NXCD, off = wgid / NXCD; wgid = (xcd < r ? xcd * (q + 1) : r * (q + 1) + (xcd - r) * q) + off; }
        const int nig = WGM * nN, gid = wgid / nig, fm = gid * WGM, gsz = (nM - fm) < WGM ? (nM - fm) : WGM;
        u.pm = fm + ((wgid % nig) % gsz); u.pn = (wgid % nig) / gsz; return true;
    }
};

template <class Epi>
__device__ __forceinline__ void gemm_phase(LAS unsigned char* lds, const Gemm g, const StaticOrder& S, const Epi& E) {
    const int tid = tid_opaque(), wid = __builtin_amdgcn_readfirstlane(tid >> 6), lane = tid & 63, wr = wid >> 2, wc = wid & 3, fr = lane & 15, fq = lane >> 4;
    const int K = g.K, nt = K / BK;
    unsigned voffA[2], voffB[2];
#pragma unroll
    for (int i = 0; i < 2; ++i) { int R, C; stage_rc(tid * 16 + i * 8192, R, C); const int Rb = Epi::PERM ? ((R & ~31) + perm32(R & 31)) : R;
        voffA[i] = (unsigned)(R * K + C) * 2u; voffB[i] = (unsigned)(Rb * K + C) * 2u; }
    const size_t kstep = (size_t)(BK * 2);
    const size_t hstep = (size_t)HALF * K * 2;
    const size_t tstep = 2 * hstep;
    const unsigned ldsw = (unsigned)wid * 1024u;
    const int aoff = lds_byte(wr * 64 + fr, fq * 8), boff = lds_byte(wc * 32 + fr, fq * 8);
#define PG8_SA(b, h) (((b) * 2 + (h)) * HTB)
#define PG8_SB(b, h) ((4 + (b) * 2 + (h)) * HTB)
#define PG8_STAGE(bufoff, gbase, voff) do { _Pragma("unroll") for (int _i = 0; _i < 2; ++_i) \
        __builtin_amdgcn_global_load_lds((const unsigned*)((const char*)(gbase) + (voff)[_i]), (LAS unsigned*)(lds + (bufoff) + ldsw + _i * 8192), 16, 0, 0); } while (0)
#define PG8_LDA(dst, b, h) do { _Pragma("unroll") for (int m = 0; m < 4; ++m) _Pragma("unroll") for (int k = 0; k < 2; ++k) dst[m][k] = *(const LAS bf16x8*)(lds + PG8_SA(b, h) + aoff + m * 2048 + k * 1024); } while (0)
#define PG8_LDB(dst, b, h) do { _Pragma("unroll") for (int n = 0; n < 2; ++n) _Pragma("unroll") for (int k = 0; k < 2; ++k) dst[n][k] = *(const LAS bf16x8*)(lds + PG8_SB(b, h) + boff + n * 2048 + k * 1024); } while (0)
#define PG8_MMA(ai, bj, At, Bt) do { __builtin_amdgcn_s_setprio(1); _Pragma("unroll") for (int m = 0; m < 4; ++m) _Pragma("unroll") for (int n = 0; n < 2; ++n) _Pragma("unroll") for (int k = 0; k < 2; ++k) \
        acc[ai][bj][m][n] = __builtin_amdgcn_mfma_f32_16x16x32_bf16(Bt[n][k], At[m][k], acc[ai][bj][m][n], 0, 0, 0); __builtin_amdgcn_s_setprio(0); } while (0)
#define PG8_WAIT_V(n) asm volatile("s_waitcnt vmcnt(" #n ")" ::: "memory")
#define PG8_WAIT_L(n) asm volatile("s_waitcnt lgkmcnt(" #n ")" ::: "memory")
#define PG8_BAR __builtin_amdgcn_s_barrier()
#define PG8_SCHED __builtin_amdgcn_sched_barrier(0)
    Unit cur, nxt; int ui = 0;
    if (!S.next(0, cur)) return;
    f32x4 acc[2][2][4][2];
#pragma unroll
    for (int a = 0; a < 2; ++a)
#pragma unroll
        for (int b = 0; b < 2; ++b)
#pragma unroll
            for (int m = 0; m < 4; ++m)
#pragma unroll
                for (int n = 0; n < 2; ++n) acc[a][b][m][n] = (f32x4){0.f, 0.f, 0.f, 0.f};
    bf16x8 At[4][2], B0[2][2], B1[2][2];
    const char* cA = (const char*)g.A + (size_t)cur.pm * tstep; const char* cB = (const char*)g.Bt + (size_t)cur.pn * tstep;
    PG8_STAGE(PG8_SB(0, 0), cB, voffB); PG8_STAGE(PG8_SA(0, 0), cA, voffA); PG8_STAGE(PG8_SB(0, 1), cB + hstep, voffB); PG8_STAGE(PG8_SA(0, 1), cA + hstep, voffA);
    if (wr == 1) PG8_BAR;
    PG8_WAIT_V(4); PG8_BAR;
    PG8_STAGE(PG8_SB(1, 0), cB + kstep, voffB); PG8_STAGE(PG8_SA(1, 0), cA + kstep, voffA); PG8_STAGE(PG8_SB(1, 1), cB + hstep + kstep, voffB);
    PG8_WAIT_V(6); PG8_BAR;
    for (;;) {
        const bool has_next = S.next(ui + 1, nxt);
        const char* nA = has_next ? (const char*)g.A + (size_t)nxt.pm * tstep : cA; const char* nB = has_next ? (const char*)g.Bt + (size_t)nxt.pn * tstep : cB;
        for (int t = 0; t < nt; t += 2) {
            const bool last = (t == nt - 2);
            const char* a1 = cA + (size_t)(t + 1) * kstep;
            const char* a2 = last ? nA : cA + (size_t)(t + 2) * kstep; const char* b2 = last ? nB : cB + (size_t)(t + 2) * kstep;
            const char* a3 = a2 + kstep; const char* b3 = b2 + kstep;
            PG8_LDB(B0, 0, 0); PG8_SCHED; PG8_LDA(At, 0, 0); PG8_STAGE(PG8_SA(1, 1), a1 + hstep, voffA);
            PG8_WAIT_L(8); PG8_BAR; PG8_WAIT_L(0); PG8_MMA(0, 0, At, B0); PG8_BAR; PG8_SCHED;
            PG8_LDB(B1, 0, 1); PG8_STAGE(PG8_SB(0, 0), b2, voffB);
            PG8_BAR; PG8_WAIT_L(0); PG8_MMA(0, 1, At, B1); PG8_BAR;
            PG8_LDA(At, 0, 1); PG8_STAGE(PG8_SA(0, 0), a2, voffA);
            PG8_BAR; PG8_WAIT_L(0); PG8_MMA(1, 0, At, B0); PG8_BAR; PG8_SCHED;
            PG8_STAGE(PG8_SB(0, 1), b2 + hstep, voffB);
            PG8_WAIT_V(6); PG8_BAR; PG8_MMA(1, 1, At, B1); PG8_BAR;
            PG8_LDB(B0, 1, 0); PG8_SCHED; PG8_LDA(At, 1, 0); PG8_STAGE(PG8_SA(0, 1), a2 + hstep, voffA);
            PG8_WAIT_L(8); PG8_BAR; PG8_WAIT_L(0); PG8_MMA(0, 0, At, B0); PG8_BAR; PG8_SCHED;
            PG8_LDB(B1, 1, 1); PG8_STAGE(PG8_SB(1, 0), b3, voffB);
            PG8_BAR; PG8_WAIT_L(0); PG8_MMA(0, 1, At, B1); PG8_BAR;
            PG8_LDA(At, 1, 1); PG8_STAGE(PG8_SA(1, 0), a3, voffA);
            PG8_BAR; PG8_WAIT_L(0); PG8_MMA(1, 0, At, B0); PG8_BAR; PG8_SCHED;
            PG8_STAGE(PG8_SB(1, 1), b3 + hstep, voffB);
            PG8_WAIT_V(6); PG8_BAR; PG8_MMA(1, 1, At, B1); PG8_BAR;
        }
        E(acc, cur, wr, wc, fr, fq);
        if (!has_next) break;
#pragma unroll
        for (int a = 0; a < 2; ++a)
#pragma unroll
            for (int b = 0; b < 2; ++b)
#pragma unroll
                for (int m = 0; m < 4; ++m)
#pragma unroll
                    for (int n = 0; n < 2; ++n) acc[a][b][m][n] = (f32x4){0.f, 0.f, 0.f, 0.f};
        cur = nxt; cA = nA; cB = nB; ++ui;
    }
    PG8_WAIT_V(0);
    if (wr == 0) PG8_BAR;
    PG8_BAR;
#undef PG8_SA
#undef PG8_SB
#undef PG8_STAGE
#undef PG8_LDA
#undef PG8_LDB
#undef PG8_MMA
#undef PG8_WAIT_V
#undef PG8_WAIT_L
#undef PG8_BAR
#undef PG8_SCHED
}
}

struct EpiProj {
    static constexpr bool PERM = true;
    bf16_t* O;
    template <int MODE> __device__ __forceinline__ void run(const f32x4 (&acc)[2][2][4][2], const pg8::Unit& u, int wr, int wc, int fr, int fq) const {
        const int row0 = u.pm * 256 + wr * 64 + fr, col0 = u.pn * 256 + wc * 32 + 8 * fq;
#pragma unroll
        for (int ai = 0; ai < 2; ++ai)
#pragma unroll
            for (int m = 0; m < 4; ++m) { bf16_t* rowp = O + (size_t)(row0 + ai * 128 + m * 16) * LDP + col0;
#pragma unroll
                for (int bj = 0; bj < 2; ++bj) { float f[8];
#pragma unroll
                    for (int q = 0; q < 8; ++q) { const float x = acc[ai][bj][m][q >> 2][q & 3];
                        f[q] = MODE == 0 ? gelu_tanh_f(x) : MODE == 1 ? silu_f(x) : MODE == 2 ? x : sigmoid_f(x); }
                    *(u32x4*)(rowp + bj * 128) = pack8(f); } }
    }
    __device__ __forceinline__ void operator()(const f32x4 (&acc)[2][2][4][2], const pg8::Unit& u, int wr, int wc, int fr, int fq) const {
        const int pn = u.pn;
        if (pn < 8) run<0>(acc, u, wr, wc, fr, fq);
        else if (pn < 12) run<1>(acc, u, wr, wc, fr, fq);
        else if (pn < 37) run<2>(acc, u, wr, wc, fr, fq);
        else if (pn < 45) run<1>(acc, u, wr, wc, fr, fq);
        else run<3>(acc, u, wr, wc, fr, fq);
    }
};
template <bool ADD> struct EpiMerge {
    static constexpr bool PERM = true;
    bf16_t* O; const bf16_t* G;
    __device__ __forceinline__ void operator()(const f32x4 (&acc)[2][2][4][2], const pg8::Unit& u, int wr, int wc, int fr, int fq) const {
        const int row0 = u.pm * 256 + wr * 64 + fr, col0 = u.pn * 256 + wc * 32 + 8 * fq;
#pragma unroll
        for (int ai = 0; ai < 2; ++ai)
#pragma unroll
            for (int m = 0; m < 4; ++m) { const size_t r = (size_t)(row0 + ai * 128 + m * 16);
#pragma unroll
                for (int bj = 0; bj < 2; ++bj) { const int c = col0 + bj * 128; float gt[8], f[8];
                    unpack8(*(const u32x4*)(G + r * LDP + c), gt);
                    if (ADD) unpack8(*(const u32x4*)(O + r * D + c), f);
#pragma unroll
                    for (int q = 0; q < 8; ++q) { const float x = acc[ai][bj][m][q >> 2][q & 3] * gt[q]; f[q] = ADD ? f[q] + x : x; }
                    *(u32x4*)(O + r * D + c) = pack8(f); } }
    }
};
struct EpiOut {
    static constexpr bool PERM = true;
    bf16_t* O; const float* xp; const float* xs; const float* mod;
    __device__ __forceinline__ void operator()(const f32x4 (&acc)[2][2][4][2], const pg8::Unit& u, int wr, int wc, int fr, int fq) const {
        const int row0 = u.pm * 256 + wr * 64 + fr, col0 = u.pn * 256 + wc * 32 + 8 * fq;
#pragma unroll
        for (int ai = 0; ai < 2; ++ai)
#pragma unroll
            for (int m = 0; m < 4; ++m) { const int r = row0 + ai * 128 + m * 16;
                if (r < NTOK) { const float* x = r < NTOK_P ? xp + (size_t)r * D : xs + (size_t)(r - NTOK_P) * D; const int b = r < NTOK_P ? (r >> 11) : 4 + (r - NTOK_P);
                    const float* gate = mod + (size_t)b * 6144 + 4096;
#pragma unroll
                    for (int bj = 0; bj < 2; ++bj) { const int c = col0 + bj * 128; float f[8];
                        const f32x4 x0 = *(const f32x4*)(x + c), x1 = *(const f32x4*)(x + c + 4), g0 = *(const f32x4*)(gate + c), g1 = *(const f32x4*)(gate + c + 4);
                        const f32x4 o0 = x0 + g0 * acc[ai][bj][m][0], o1 = x1 + g1 * acc[ai][bj][m][1];
                        f[0] = o0[0]; f[1] = o0[1]; f[2] = o0[2]; f[3] = o0[3]; f[4] = o1[0]; f[5] = o1[1]; f[6] = o1[2]; f[7] = o1[3];
                        *(u32x4*)(O + (size_t)r * D + c) = pack8(f); } } }
    }
};

typedef float f32x16 __attribute__((ext_vector_type(16)));
template <class Epi> __device__ __forceinline__ void small_gemm(const bf16_t* __restrict__ A, const bf16_t* __restrict__ Bt, int K, LAS float* red, const Epi& epi) {
    const int tid = tid_opaque(), wid = tid >> 6, lane = tid & 63, l31 = lane & 31, lh = lane >> 5;
    for (int tile = blockIdx.x; tile < 256; tile += gridDim.x) {
        const int r0 = (tile & 3) * 32, n0 = (tile >> 2) * 32, kw = wid * (K >> 3), ns = K >> 7;
        const bf16_t* ap = A + (size_t)(r0 + l31) * K + kw + lh * 8; const bf16_t* bp = Bt + (size_t)(n0 + l31) * K + kw + lh * 8;
        f32x16 acc;
#pragma unroll
        for (int v = 0; v < 16; ++v) acc[v] = 0.f;
#pragma unroll 8
        for (int st = 0; st < ns; ++st) { const bf16x8 af = *(const bf16x8*)(ap + st * 16), bf = *(const bf16x8*)(bp + st * 16);
            acc = __builtin_amdgcn_mfma_f32_32x32x16_bf16(bf, af, acc, 0, 0, 0); }
#pragma unroll
        for (int v = 0; v < 16; ++v) red[(wid * 16 + v) * 64 + lane] = acc[v];
        __syncthreads();
        if (tid < 256) { const int g = tid >> 6; f32x4 sum = (f32x4){0.f, 0.f, 0.f, 0.f};
#pragma unroll
            for (int w = 0; w < 8; ++w)
#pragma unroll
                for (int j = 0; j < 4; ++j) sum[j] += red[(w * 16 + g * 4 + j) * 64 + lane];
            epi(sum, r0 + l31, n0 + 8 * g + 4 * lh); }
        __syncthreads();
    }
}

__device__ void mod_tile(PP p, int tile, LAS float* red) {
    const int tid = tid_opaque(), wid = tid >> 6, lane = tid & 63, fr = lane & 15, fq = lane >> 4, n0 = tile * 32;
    const float* wc = p->in[I_WC];
    f32x4 acc[9][2];
#pragma unroll
    for (int a = 0; a < 9; ++a) { acc[a][0] = (f32x4){0.f, 0.f, 0.f, 0.f}; acc[a][1] = (f32x4){0.f, 0.f, 0.f, 0.f}; }
    float bw[2][8], bn[2][8];
#pragma unroll
    for (int nt = 0; nt < 2; ++nt)
#pragma unroll
        for (int j = 0; j < 8; ++j) bw[nt][j] = wc[(size_t)(wid * 256 + fq * 8 + j) * 6144 + n0 + nt * 16 + fr];
#pragma unroll 1
    for (int ks = 0; ks < 8; ++ks) { const int k0 = wid * 256 + ks * 32 + fq * 8;
        if (ks + 1 < 8) {
#pragma unroll
            for (int nt = 0; nt < 2; ++nt)
#pragma unroll
                for (int j = 0; j < 8; ++j) bn[nt][j] = wc[(size_t)(k0 + 32 + j) * 6144 + n0 + nt * 16 + fr]; }
        f32x4 av[9][2];
#pragma unroll
        for (int mt = 0; mt < 9; ++mt) { const int r = mt * 16 + fr;
            if (r < NMODROW) { const float* cp = (r < 4 ? p->in[I_CP] + (size_t)r * D : p->in[I_CS] + (size_t)(r - 4) * D) + k0; av[mt][0] = *(const f32x4*)cp; av[mt][1] = *(const f32x4*)(cp + 4); }
            else { av[mt][0] = (f32x4){0.f, 0.f, 0.f, 0.f}; av[mt][1] = av[mt][0]; } }
        bf16x8 bfr[2];
#pragma unroll
        for (int nt = 0; nt < 2; ++nt) { const u32x4 pk = pack8(bw[nt]); bfr[nt] = __builtin_bit_cast(bf16x8, pk); }
#pragma unroll
        for (int mt = 0; mt < 9; ++mt) { u32x4 pk; pk[0] = cvt_pk_bf16(av[mt][0][0], av[mt][0][1]); pk[1] = cvt_pk_bf16(av[mt][0][2], av[mt][0][3]); pk[2] = cvt_pk_bf16(av[mt][1][0], av[mt][1][1]); pk[3] = cvt_pk_bf16(av[mt][1][2], av[mt][1][3]);
            const bf16x8 afr = __builtin_bit_cast(bf16x8, pk);
            acc[mt][0] = __builtin_amdgcn_mfma_f32_16x16x32_bf16(afr, bfr[0], acc[mt][0], 0, 0, 0);
            acc[mt][1] = __builtin_amdgcn_mfma_f32_16x16x32_bf16(afr, bfr[1], acc[mt][1], 0, 0, 0); }
#pragma unroll
        for (int nt = 0; nt < 2; ++nt)
#pragma unroll
            for (int j = 0; j < 8; ++j) bw[nt][j] = bn[nt][j];
    }
    if (wid >= 4) {
#pragma unroll
        for (int mt = 0; mt < 9; ++mt)
#pragma unroll
            for (int nt = 0; nt < 2; ++nt)
#pragma unroll
                for (int j = 0; j < 4; ++j) red[(wid - 4) * 4608 + (mt * 16 + fq * 4 + j) * 32 + nt * 16 + fr] = acc[mt][nt][j]; }
    __syncthreads();
    if (wid < 4) {
#pragma unroll
        for (int mt = 0; mt < 9; ++mt)
#pragma unroll
            for (int nt = 0; nt < 2; ++nt)
#pragma unroll
                for (int j = 0; j < 4; ++j) red[wid * 4608 + (mt * 16 + fq * 4 + j) * 32 + nt * 16 + fr] += acc[mt][nt][j]; }
    __syncthreads();
    float* mod = (float*)(p->ws + WS_MOD); const float* bc = p->in[I_BC];
    for (int i = tid; i < NMODROW * 32; i += 512) { const int r = i >> 5, c = i & 31; mod[(size_t)r * 6144 + n0 + c] = ((red[i] + red[4608 + i]) + (red[9216 + i] + red[13824 + i])) + bc[n0 + c]; }
    __syncthreads();
}
constexpr int T0_MOD = 192, T0_WIN = 8 * 243, T0_PA = 4 * 32, T0_PB = 8 * 32, T0_WOUT = 8 * 32, NCONV_ALL = T0_WIN + T0_PA + T0_PB + T0_WOUT;
__device__ __forceinline__ void conv_desc(PP p, int u, const float*& sp, int& Nsrc, bf16_t*& dp, int& K) {
    if (u < T0_WIN) { const int tn = u >> 3, tk = u & 7; Nsrc = IN_W; K = D; sp = p->in[I_WIN] + (size_t)tk * 256 * IN_W + tn * 64; dp = (bf16_t*)(p->ws + WS_WTIN) + (size_t)(tn * 64 + (tn >= 147 ? 64 : 0)) * D + tk * 256; return; }
    u -= T0_WIN; Nsrc = D;
    if (u < T0_PA) { const int tk = u & 3, tn = u >> 2; K = A_W; sp = p->in[I_PA] + (size_t)tk * 256 * D + tn * 64; dp = (bf16_t*)(p->ws + WS_WTPA) + (size_t)tn * 64 * A_W + tk * 256; return; }
    u -= T0_PA; K = D; const int tk = u & 7, tn = (u >> 3) & 31;
    if (u < T0_PB) { sp = p->in[I_PB] + (size_t)tk * 256 * D + tn * 64; dp = (bf16_t*)(p->ws + WS_WTPB) + (size_t)tn * 64 * D + tk * 256; return; }
    { sp = p->in[I_WOUT] + (size_t)tk * 256 * D + tn * 64; dp = (bf16_t*)(p->ws + WS_WTOUT) + (size_t)tn * 64 * D + tk * 256; }
}
__device__ void phase0(PP p, LAS unsigned char* lds) {
    const int tid = tid_opaque();
    REP(13) for (int t = blockIdx.x; t < T0_MOD; t += gridDim.x) mod_tile(p, t, (LAS float*)lds);
    const int rb = gridDim.x - 1 - blockIdx.x;
    if (rb == 0) { u32x4* z = (u32x4*)(p->ws + WS_WTIN + (size_t)9408 * D * 2); for (int i = tid; i < 64 * D * 2 / 16; i += 512) z[i] = (u32x4){0u, 0u, 0u, 0u}; }
    for (int it = blockIdx.x; it < 256; it += gridDim.x) { const int w = it >> 7, n0 = (it & 127) * 16; const float* src = p->in[w ? I_A2 : I_W2]; bf16_t* dst = (bf16_t*)(p->ws + (w ? WS_A2T : WS_W2T));
#pragma unroll
        for (int j = 0; j < 3; ++j) { const int i = tid + j * 512, nl = i / 96, k = i % 96; dst[(size_t)(n0 + nl) * 96 + k] = f2bf(src[(size_t)k * B_W + n0 + nl]); } }
    LAS float* t = (LAS float*)lds; volatile LAS int* slot = (volatile LAS int*)(lds + 256 * 65 * 4);
    unsigned* q = (unsigned*)(p->ws + WS_BAR) + 64;
    __syncthreads();
    if (tid == 0) slot[0] = (int)atomicAdd(q, 2u);
    __syncthreads();
    const int NCONV = (gridDim.x == 256) ? T0_WIN : NCONV_ALL;
    int cur = slot[0], nxt = cur + 1;
    f32x4 rg[8], rn[8];
    auto load = [&](int u, f32x4 (&r)[8]) { const float* sp; int Nsrc, K; bf16_t* dp; conv_desc(p, u, sp, Nsrc, dp, K);
#pragma unroll
        for (int i = 0; i < 8; ++i) { const int idx = tid + i * 512; r[i] = *(const f32x4*)(sp + (size_t)(idx >> 4) * Nsrc + (idx & 15) * 4); } };
    if (cur < NCONV) load(cur, rg);
    while (cur < NCONV) {
        int claimed = 0;
        if (tid == 0) claimed = (int)atomicAdd(q, 1u);
        if (nxt < NCONV) load(nxt, rn);
        __syncthreads();
        if (tid == 0) slot[0] = claimed;
#pragma unroll
        for (int i = 0; i < 8; ++i) { const int idx = tid + i * 512, row = idx >> 4, cb = (idx & 15) * 4, hx = (row >> 5) & 7;
            t[row * 65 + (cb ^ hx)] = rg[i][0]; t[row * 65 + ((cb + 1) ^ hx)] = rg[i][1]; t[row * 65 + ((cb + 2) ^ hx)] = rg[i][2]; t[row * 65 + ((cb + 3) ^ hx)] = rg[i][3]; }
        __syncthreads();
        const int n2 = slot[0];
        { const float* sp; int Nsrc, K; bf16_t* dp; conv_desc(p, cur, sp, Nsrc, dp, K);
#pragma unroll
            for (int i = 0; i < 4; ++i) { const int ch = tid + i * 512, nl = ch >> 5, kc = ch & 31; float f[8];
#pragma unroll
                for (int j = 0; j < 8; ++j) f[j] = t[(kc * 8 + j) * 65 + (nl ^ ((kc >> 2) & 7))];
                *(u32x4*)(dp + (size_t)nl * K + kc * 8) = pack8(f); } }
        cur = nxt; nxt = n2;
#pragma unroll
        for (int i = 0; i < 8; ++i) rg[i] = rn[i];
    }
    __syncthreads();
}

__device__ void phase1(PP p) {
    const int tid = tid_opaque(), lane = tid & 63, gw = blockIdx.x * 8 + (tid >> 6), nw = gridDim.x * 8;
    bf16_t* H = (bf16_t*)(p->ws + WS_H); const float* mod = (const float*)(p->ws + WS_MOD); const float* ng = p->in[I_NORMG];
    f32x4 g[8];
#pragma unroll
    for (int i = 0; i < 8; ++i) g[i] = *(const f32x4*)(ng + (lane + 64 * i) * 4);
    auto xrow = [&](int r) { return r < NTOK_P ? p->in[I_XP] + (size_t)r * D : p->in[I_XS] + (size_t)(r - NTOK_P) * D; };
    f32x4 v[8], vn[8];
    if (gw < NTOK) {
#pragma unroll
        for (int i = 0; i < 8; ++i) v[i] = *(const f32x4*)(xrow(gw) + (lane + 64 * i) * 4); }
    for (int r = gw; r < MP; r += nw) {
        bf16_t* hrow = H + (size_t)r * D;
        if (r >= NTOK) { for (int i = 0; i < 4; ++i) *(u32x4*)(hrow + (lane + 64 * i) * 8) = (u32x4){0u, 0u, 0u, 0u}; continue; }
        const int rn = r + nw;
        if (rn < NTOK) {
#pragma unroll
            for (int i = 0; i < 8; ++i) vn[i] = *(const f32x4*)(xrow(rn) + (lane + 64 * i) * 4); }
        const int b = r < NTOK_P ? (r >> 11) : 4 + (r - NTOK_P);
        const float* mrow = mod + (size_t)b * 6144;
        float ss = 0.f;
#pragma unroll
        for (int i = 0; i < 8; ++i) ss += v[i][0] * v[i][0] + v[i][1] * v[i][1] + v[i][2] * v[i][2] + v[i][3] * v[i][3];
        ss = wave_sum(ss); const float rstd = rsqrtf(ss * (1.f / D) + 1e-6f);
#pragma unroll
        for (int i = 0; i < 8; ++i) { const int c = (lane + 64 * i) * 4; const f32x4 sh = *(const f32x4*)(mrow + c), sc = *(const f32x4*)(mrow + 2048 + c);
            const f32x4 h = v[i] * rstd * g[i] * (sc + 1.f) + sh; u32x2 o; o[0] = cvt_pk_bf16(h[0], h[1]); o[1] = cvt_pk_bf16(h[2], h[3]); *(u32x2*)(hrow + c) = o; }
#pragma unroll
        for (int i = 0; i < 8; ++i) v[i] = vn[i];
    }
}

__device__ void mixa_tile(PP p, int tile, LAS unsigned char* lds) {
    const int tid = tid_opaque(), wid = tid >> 6, lane = tid & 63, fr = lane & 15, fq = lane >> 4;
    const int b = tile >> 7, nck = (tile >> 3) & 15, g = tile & 7, row0 = b * SEQ + nck * 128;
    const bf16_t* PROJ = (const bf16_t*)(p->ws + WS_PROJ); bf16_t* YA = (bf16_t*)(p->ws + WS_YA);
    LAS float* mu = (LAS float*)lds; LAS float* rs = mu + 128;
    LAS bf16_t* wA = (LAS bf16_t*)(lds + 1024); LAS bf16_t* vT = wA + 128 * 136;
#pragma unroll
    for (int hb = 0; hb < 2; ++hb) { u32x4 ra[8], rc[8];
#pragma unroll
        for (int k = 0; k < 8; ++k) { const bf16_t* vr = PROJ + (size_t)(row0 + wid * 16 + hb * 8 + k) * LDP + C_VA; ra[k] = *(const u32x4*)(vr + lane * 8); rc[k] = *(const u32x4*)(vr + 512 + lane * 8); }
#pragma unroll
        for (int k = 0; k < 8; ++k) { float a[8], c[8]; unpack8(ra[k], a); unpack8(rc[k], c); float s = 0.f, s2 = 0.f;
#pragma unroll
            for (int q = 0; q < 8; ++q) { s += a[q] + c[q]; s2 += a[q] * a[q] + c[q] * c[q]; }
            s = wave_sum(s); s2 = wave_sum(s2); const float m = s * (1.f / A_W), var = fmaxf(s2 * (1.f / A_W) - m * m, 0.f);
            if (lane == 0) { const int tl = wid * 16 + hb * 8 + k; mu[tl] = m; rs[tl] = rsqrtf(var + 1e-6f); } } }
    const float* wsrc = p->in[I_WS] + (size_t)g * 128 * 128;
#pragma unroll
    for (int i = 0; i < 8; ++i) { const int idx = tid + i * 512, t = idx >> 5, s4 = (idx & 31) * 4; const f32x4 w = *(const f32x4*)(wsrc + t * 128 + s4);
        u32x2 o; o[0] = cvt_pk_bf16(s4 <= t ? w[0] : 0.f, s4 + 1 <= t ? w[1] : 0.f); o[1] = cvt_pk_bf16(s4 + 2 <= t ? w[2] : 0.f, s4 + 3 <= t ? w[3] : 0.f);
        *(LAS u32x2*)(wA + t * 136 + s4) = o; }
    __syncthreads();
    const float* lng = p->in[I_LNG] + g * 128; const float* lnb = p->in[I_LNB] + g * 128;
    u32x4 uar[4], zar[4];
    { const int rowe = row0 + wid * 16 + fr;
#pragma unroll
      for (int k2 = 0; k2 < 4; ++k2) { const int c = g * 128 + k2 * 32 + 8 * fq; uar[k2] = *(const u32x4*)(PROJ + (size_t)rowe * LDP + C_UA + c); zar[k2] = *(const u32x4*)(PROJ + (size_t)rowe * LDP + C_ZA + c); } }
#pragma unroll
    for (int i = 0; i < 4; ++i) { const int idx = tid + i * 512, s = idx >> 4, c8 = (idx & 15) * 8; float x[8];
        unpack8(*(const u32x4*)(PROJ + (size_t)(row0 + s) * LDP + C_VA + g * 128 + c8), x); const float m = mu[s], r = rs[s];
        const f32x4 g0 = *(const f32x4*)(lng + c8), g1 = *(const f32x4*)(lng + c8 + 4), b0 = *(const f32x4*)(lnb + c8), b1 = *(const f32x4*)(lnb + c8 + 4);
        const int ssw = s ^ (((c8 >> 3) & 7) << 3);
#pragma unroll
        for (int q = 0; q < 8; ++q) vT[(c8 + q) * 136 + ssw] = f2bf((x[q] - m) * r * (q < 4 ? g0[q & 3] : g1[q & 3]) + (q < 4 ? b0[q & 3] : b1[q & 3])); }
    __syncthreads();
    const int t0 = wid * 16, nks = (t0 + 15) / 32 + 1;
    bf16x8 af[4];
#pragma unroll
    for (int ks = 0; ks < 4; ++ks) af[ks] = *(const LAS bf16x8*)(wA + (t0 + fr) * 136 + (ks < nks ? ks : 0) * 32 + fq * 8);
    const int row = row0 + t0 + fr; const float bias = p->in[I_BS][g * 128 + t0 + fr];
#pragma unroll
    for (int k2 = 0; k2 < 4; ++k2) { u32x4 o;
#pragma unroll
        for (int n1 = 0; n1 < 2; ++n1) { f32x4 acc = (f32x4){0.f, 0.f, 0.f, 0.f}; const int cch = k2 * 32 + 8 * (fr >> 2) + 4 * n1 + (fr & 3);
#pragma unroll
            for (int ks = 0; ks < 4; ++ks) if (ks < nks) { const bf16x8 bfr = *(const LAS bf16x8*)(vT + cch * 136 + ((ks * 32 + fq * 8) ^ (((cch >> 3) & 7) << 3)));
                acc = __builtin_amdgcn_mfma_f32_16x16x32_bf16(bfr, af[ks], acc, 0, 0, 0); }
            const unsigned ua0 = uar[k2][n1 * 2], ua1 = uar[k2][n1 * 2 + 1], za0 = zar[k2][n1 * 2], za1 = zar[k2][n1 * 2 + 1];
            o[n1 * 2] = cvt_pk_bf16(bflo(ua0) * (acc[0] + bias) * bflo(za0), bfhi(ua0) * (acc[1] + bias) * bfhi(za0));
            o[n1 * 2 + 1] = cvt_pk_bf16(bflo(ua1) * (acc[2] + bias) * bflo(za1), bfhi(ua1) * (acc[3] + bias) * bfhi(za1)); }
        *(u32x4*)(YA + (size_t)row * A_W + g * 128 + k2 * 32 + 8 * fq) = o; }
    __syncthreads();
}
__device__ void mixa_sample_row(PP p, int bs) {
    const int lane = tid_opaque() & 63, row = NTOK_P + bs;
    const bf16_t* pr = (const bf16_t*)(p->ws + WS_PROJ) + (size_t)row * LDP; bf16_t* YA = (bf16_t*)(p->ws + WS_YA) + (size_t)row * A_W; float* cv = p->out + O_CV + (size_t)bs * A_W;
    float x[2][8]; unpack8(*(const u32x4*)(pr + C_VA + lane * 8), x[0]); unpack8(*(const u32x4*)(pr + C_VA + 512 + lane * 8), x[1]);
    float s = 0.f, s2 = 0.f;
#pragma unroll
    for (int q = 0; q < 8; ++q) { s += x[0][q] + x[1][q]; s2 += x[0][q] * x[0][q] + x[1][q] * x[1][q]; }
    s = wave_sum(s); s2 = wave_sum(s2); const float m = s * (1.f / A_W), r = rsqrtf(fmaxf(s2 * (1.f / A_W) - m * m, 0.f) + 1e-6f);
#pragma unroll
    for (int hlf = 0; hlf < 2; ++hlf) { const int c0 = hlf * 512 + lane * 8, g = c0 >> 7; const float w00 = p->in[I_WS][(size_t)g * 128 * 128], b0 = p->in[I_BS][g * 128];
        float ua[8], za[8], f[8], vn[8]; unpack8(*(const u32x4*)(pr + C_UA + c0), ua); unpack8(*(const u32x4*)(pr + C_ZA + c0), za);
#pragma unroll
        for (int q = 0; q < 8; ++q) { vn[q] = (x[hlf][q] - m) * r * p->in[I_LNG][c0 + q] + p->in[I_LNB][c0 + q]; f[q] = ua[q] * (w00 * vn[q] + b0) * za[q]; }
        *(f32x4*)(cv + c0) = (f32x4){vn[0], vn[1], vn[2], vn[3]}; *(f32x4*)(cv + c0 + 4) = (f32x4){vn[4], vn[5], vn[6], vn[7]};
        *(u32x4*)(YA + c0) = pack8(f); }
}

template <bool SMP> __device__ __forceinline__ void lora_stage(PP p, int T0, int tid, LAS bf16_t* Aw, LAS bf16_t* Aa) {
    const bf16_t* PROJ = (const bf16_t*)(p->ws + WS_PROJ); const float* mu = p->in[I_MU];
#pragma unroll 1
    for (int hb = 0; hb < 2; ++hb) {
        u32x4 cur[4], prv[4]; f32x4 pf0[4], pf1[4];
#pragma unroll
        for (int k = 0; k < 4; ++k) { const int idx = tid + (hb * 4 + k) * 512, which = idx >= 144 * 12, i2 = which ? idx - 144 * 12 : idx, tl = i2 / 12, ch = i2 % 12, row = T0 + tl, off = (which ? PR_AD : PR_WD) + ch * 8;
            const bool act = idx < 144 * 12 * 2 && tl < 130 && (SMP ? row >= NTOK_P : row < NTOK_P);
            const int srow = act ? row : T0;
            const bf16_t* pr = PROJ + (size_t)srow * LDP + C_PR + off; cur[k] = *(const u32x4*)pr;
            if (SMP) { const float* sh = p->in[I_SSH] + (size_t)(act ? row - NTOK_P : 0) * SHIFT_W + off; pf0[k] = *(const f32x4*)sh; pf1[k] = *(const f32x4*)(sh + 4); prv[k] = cur[k]; }
            else { const bool first = !act || (srow & (SEQ - 1)) == 0; prv[k] = *(const u32x4*)(first ? pr : pr - LDP); pf0[k] = (f32x4){0.f, 0.f, 0.f, 0.f}; pf1[k] = pf0[k]; } }
#pragma unroll
        for (int k = 0; k < 4; ++k) { const int idx = tid + (hb * 4 + k) * 512, which = idx >= 144 * 12, i2 = which ? idx - 144 * 12 : idx, tl = i2 / 12, ch = i2 % 12, row = T0 + tl, off = (which ? PR_AD : PR_WD) + ch * 8;
            const bool inr = idx < 144 * 12 * 2, act = inr && tl < 130 && (SMP ? row >= NTOK_P : row < NTOK_P);
            const f32x4 m0 = *(const f32x4*)(mu + off), m1 = *(const f32x4*)(mu + off + 4);
            float c[8], pv[8], f[8]; unpack8(cur[k], c);
            if (SMP) { pv[0] = pf0[k][0]; pv[1] = pf0[k][1]; pv[2] = pf0[k][2]; pv[3] = pf0[k][3]; pv[4] = pf1[k][0]; pv[5] = pf1[k][1]; pv[6] = pf1[k][2]; pv[7] = pf1[k][3]; }
            else { unpack8(prv[k], pv); const float keep = (row & (SEQ - 1)) == 0 ? 0.f : 1.f;
#pragma unroll
                for (int q = 0; q < 8; ++q) pv[q] *= keep; }
#pragma unroll
            for (int q = 0; q < 8; ++q) { const float x = c[q] + (q < 4 ? m0[q & 3] : m1[q & 3]) * (pv[q] - c[q]); f[q] = which ? x : tanh_fast(x); }
            const u32x4 o = act ? pack8(f) : (u32x4){0u, 0u, 0u, 0u};
            if (SMP ? act : (inr && (tl >= 130 || row < NTOK_P))) *(LAS u32x4*)((which ? Aa : Aw) + tl * 104 + ch * 8) = o; }
    }
}
__device__ void lora_tile(PP p, int tile, LAS unsigned char* lds) {
    const int tid = tid_opaque(), wid = tid >> 6, lane = tid & 63, fr = lane & 15, fq = lane >> 4, cs = tile & 3, T0 = (tile >> 2) * 130;
    const bf16_t* PROJ = (const bf16_t*)(p->ws + WS_PROJ); const float* mu = p->in[I_MU];
    LAS bf16_t* Aw = (LAS bf16_t*)lds; LAS bf16_t* Aa = Aw + 144 * 104;
    bf16x8 bfr[2][4][3]; f32x4 bias[2][4];
#pragma unroll
    for (int lo = 0; lo < 2; ++lo) { const bf16_t* Bt = (const bf16_t*)(p->ws + (lo ? WS_A2T : WS_W2T)); const float* b0 = p->in[lo ? I_A0 : I_W0];
#pragma unroll
        for (int nt = 0; nt < 4; ++nt) { const int base = cs * 512 + wid * 64 + (nt >> 1) * 32, n1 = nt & 1;
            bias[lo][nt] = *(const f32x4*)(b0 + base + 8 * fq + 4 * n1);
#pragma unroll
            for (int ks = 0; ks < 3; ++ks) bfr[lo][nt][ks] = *(const bf16x8*)(Bt + (size_t)(base + 8 * (fr >> 2) + 4 * n1 + (fr & 3)) * 96 + ks * 32 + fq * 8); } }
    lora_stage<false>(p, T0, tid, Aw, Aa);
    if (T0 + 130 > NTOK_P) lora_stage<true>(p, T0, tid, Aw, Aa);
    __syncthreads();
#pragma unroll 1
    for (int mt = 0; mt < 9; ++mt) { const int tl = mt * 16 + fr, row = T0 + tl; const bool ok = tl < 130;
#pragma unroll
        for (int lo = 0; lo < 2; ++lo) { const LAS bf16_t* A = lo ? Aa : Aw; bf16x8 af[3];
#pragma unroll
            for (int ks = 0; ks < 3; ++ks) af[ks] = *(const LAS bf16x8*)(A + tl * 104 + ks * 32 + fq * 8);
            bf16_t* op = lo ? (bf16_t*)(p->ws + WS_AAA) + (size_t)row * D : (row >= NTOK_P ? (bf16_t*)(p->ws + WS_ES) + (size_t)(row - NTOK_P) * D : (bf16_t*)(p->ws + WS_E) + (size_t)row * D);
            const float mul = lo ? 1.f : 0.6065306597126334f;
#pragma unroll
            for (int k2 = 0; k2 < 2; ++k2) { u32x4 o;
#pragma unroll
                for (int n1 = 0; n1 < 2; ++n1) { const int nt = k2 * 2 + n1; f32x4 acc = (f32x4){0.f, 0.f, 0.f, 0.f};
#pragma unroll
                    for (int ks = 0; ks < 3; ++ks) acc = __builtin_amdgcn_mfma_f32_16x16x32_bf16(bfr[lo][nt][ks], af[ks], acc, 0, 0, 0);
                    o[n1 * 2] = cvt_pk_bf16(sigmoid_f(acc[0] + bias[lo][nt][0]) * mul, sigmoid_f(acc[1] + bias[lo][nt][1]) * mul); o[n1 * 2 + 1] = cvt_pk_bf16(sigmoid_f(acc[2] + bias[lo][nt][2]) * mul, sigmoid_f(acc[3] + bias[lo][nt][3]) * mul); }
                if (ok) *(u32x4*)(op + cs * 512 + wid * 64 + k2 * 32 + 8 * fq) = o; } } }
    __syncthreads();
}
constexpr int T3_MIXA = 512, T3_MIXS = 16, T3_LORA = 256, T3_TOTAL = T3_MIXA + T3_MIXS + T3_LORA;
__device__ void phase3(PP p, LAS unsigned char* lds) {
    REP(11) for (int t = blockIdx.x; t < T3_MIXA + T3_MIXS; t += gridDim.x) {
        if (t < T3_MIXA) mixa_tile(p, t, lds);
        else mixa_sample_row(p, (t - T3_MIXA) * 8 + (tid_opaque() >> 6));
    }
    REP(12) for (int t = blockIdx.x; t < T3_LORA; t += gridDim.x) lora_tile(p, (t + 16) % T3_LORA, lds);
}

struct HeadPar { float mu_r, mu_k, mu_v, kk_s, ka, rk; };
__device__ __forceinline__ float head_vectors(const HeadPar& hp, float r_c, float k_c, float v_c, float r_p, float k_p, float v_p, float a, float e, LAS float* dst, int j, float& v_out) {
    const float r = r_c + hp.mu_r * (r_p - r_c), k = k_c + hp.mu_k * (k_p - k_c), v = v_c + hp.mu_v * (v_p - v_c);
    const float w = __expf(-e);
    float kk = k * hp.kk_s; const float n2 = wave_sum(kk * kk); kk = kk / fmaxf(sqrtf(n2), 1e-12f);
    const float kp = k * (1.f + (a - 1.f) * hp.ka), bb = kk * a;
    const float cc = wave_sum(r * kp * hp.rk);
    dst[j] = r; dst[64 + j] = w; dst[128 + j] = kp; dst[192 + j] = kk; dst[256 + j] = bb; dst[320 + j] = v; v_out = v;
    return cc;
}
struct SmpRegs { f32x4 S[16]; bf16_t r_c, k_c, v_c, e, a, zb; float r_p, k_p, v_p, gng, gnb; HeadPar hp; };
__device__ __forceinline__ void smp_load(PP p, int item, SmpRegs& R, int lane_) {
    int lane = lane_; asm volatile("" : "+v"(lane));
    const int bs = item >> 5, h = item & 31, hc = h * 64 + lane; const size_t row = NTOK_P + bs;
    const bf16_t* PROJ = (const bf16_t*)(p->ws + WS_PROJ);
    const bf16_t* pr = PROJ + row * LDP + C_PR + hc; const float* sh = p->in[I_SSH] + (size_t)bs * SHIFT_W + hc;
    R.r_c = pr[PR_R]; R.k_c = pr[PR_K]; R.v_c = pr[PR_V]; R.r_p = sh[PR_R]; R.k_p = sh[PR_K]; R.v_p = sh[PR_V];
    R.e = ((const bf16_t*)(p->ws + WS_ES))[(size_t)bs * D + hc]; R.a = ((const bf16_t*)(p->ws + WS_AAA))[row * D + hc]; R.zb = PROJ[row * LDP + C_ZB + hc];
    R.hp.mu_r = p->in[I_MU][PR_R + hc]; R.hp.mu_k = p->in[I_MU][PR_K + hc]; R.hp.mu_v = p->in[I_MU][PR_V + hc]; R.hp.kk_s = p->in[I_KK][hc]; R.hp.ka = p->in[I_KA][hc]; R.hp.rk = p->in[I_RK][hc];
    R.gng = p->in[I_GNG][hc]; R.gnb = p->in[I_GNB][hc];
    const float* s0 = p->in[I_SWKV] + ((size_t)(bs * 32 + h) * 64 + lane) * 64;
#pragma unroll
    for (int q = 0; q < 16; ++q) R.S[q] = *(const f32x4*)(s0 + q * 4);
}
__device__ __forceinline__ void smp_finish(PP p, int item, SmpRegs& R, LAS float* wl, int lane_) {
    int lane = lane_; asm volatile("" : "+v"(lane));
    const int bs = item >> 5, h = item & 31, hc = h * 64 + lane; const size_t row = NTOK_P + bs;
    float v; const float cc = head_vectors(R.hp, bf2f(R.r_c), bf2f(R.k_c), bf2f(R.v_c), R.r_p, R.k_p, R.v_p, bf2f(R.a), bf2f(R.e), wl, lane, v);
    __builtin_amdgcn_wave_barrier();
    float* s1 = p->out + O_WKVS + ((size_t)(bs * 32 + h) * 64 + lane) * 64;
    float sp = 0.f;
#pragma unroll
    for (int q = 0; q < 16; ++q) { const f32x4 kk = *(const LAS f32x4*)(wl + 192 + q * 4); sp += R.S[q][0] * kk[0] + R.S[q][1] * kk[1] + R.S[q][2] * kk[2] + R.S[q][3] * kk[3]; if ((q & 3) == 3) __builtin_amdgcn_sched_barrier(0); }
    const float sa = -sp; float y = 0.f;
#pragma unroll
    for (int q = 0; q < 16; ++q) { const f32x4 w = *(const LAS f32x4*)(wl + 64 + q * 4), bb = *(const LAS f32x4*)(wl + 256 + q * 4), kp = *(const LAS f32x4*)(wl + 128 + q * 4), r = *(const LAS f32x4*)(wl + q * 4);
        const f32x4 sn = R.S[q] * w + sa * bb + v * kp; y += sn[0] * r[0] + sn[1] * r[1] + sn[2] * r[2] + sn[3] * r[3]; *(f32x4*)(s1 + q * 4) = sn; if ((q & 1) == 1) __builtin_amdgcn_sched_barrier(0); }
    const float m = wave_sum(y) * (1.f / 64.f), d = y - m, var = wave_sum(d * d) * (1.f / 64.f);
    const float yn = d * rsqrtf(var + 64e-5f) * R.gng + R.gnb;
    ((bf16_t*)(p->ws + WS_YB))[row * D + hc] = f2bf((yn + cc * v) * bf2f(R.zb));
    __builtin_amdgcn_wave_barrier();
}
__device__ void scan_sample_item(PP p, int item, LAS float* wl) {
    const int lane = tid_opaque() & 63; SmpRegs R; smp_load(p, item, R, lane); smp_finish(p, item, R, wl, lane);
}
constexpr int BGC_PA = 32 * 32, BGC_PB = 64 * 32, BGC_WO = 64 * 32, BGC_TOTAL = BGC_PA + BGC_PB + BGC_WO, BGC_WAVES = 768;
struct BgcRegs { f32x4 r[8]; };
__device__ __forceinline__ void bgc_desc(PP p, int u, const float*& sp, bf16_t*& dp, int& K) {
    if (u < BGC_PA) { const int tk = u & 31, tn = u >> 5; K = A_W; sp = p->in[I_PA] + (size_t)tk * 32 * D + tn * 64; dp = (bf16_t*)(p->ws + WS_WTPA) + (size_t)tn * 64 * A_W + tk * 32; return; }
    u -= BGC_PA; K = D; const int tk = u & 63, tn = (u >> 6) & 31;
    if (u < BGC_PB) { sp = p->in[I_PB] + (size_t)tk * 32 * D + tn * 64; dp = (bf16_t*)(p->ws + WS_WTPB) + (size_t)tn * 64 * D + tk * 32; return; }
    sp = p->in[I_WOUT] + (size_t)tk * 32 * D + tn * 64; dp = (bf16_t*)(p->ws + WS_WTOUT) + (size_t)tn * 64 * D + tk * 32;
}
__device__ __forceinline__ void bgc_load(PP p, int u, BgcRegs& R, int lane_) {
    int lane = lane_; asm volatile("" : "+v"(lane));
    const float* sp; bf16_t* dp; int K; bgc_desc(p, u, sp, dp, K);
#pragma unroll
    for (int i = 0; i < 8; ++i) { const int idx = lane + 64 * i; R.r[i] = *(const f32x4*)(sp + (size_t)(idx >> 4) * D + (idx & 15) * 4); }
}
__device__ __forceinline__ void bgc_finish(PP p, int u, const BgcRegs& R, LAS float* t, int lane_) {
    int lane = lane_; asm volatile("" : "+v"(lane));
    const float* sp; bf16_t* dp; int K; bgc_desc(p, u, sp, dp, K);
#pragma unroll
    for (int i = 0; i < 8; ++i) { const int idx = lane + 64 * i, o = (idx >> 4) * 65 + (idx & 15) * 4; t[o] = R.r[i][0]; t[o + 1] = R.r[i][1]; t[o + 2] = R.r[i][2]; t[o + 3] = R.r[i][3]; }
    __builtin_amdgcn_wave_barrier();
#pragma unroll
    for (int i = 0; i < 4; ++i) { const int ch = lane + 64 * i, nl = ch >> 2, kc = ch & 3; float f[8];
#pragma unroll
        for (int j = 0; j < 8; ++j) f[j] = t[(kc * 8 + j) * 65 + nl];
        *(u32x4*)(dp + (size_t)nl * K + kc * 8) = pack8(f); }
    __builtin_amdgcn_wave_barrier();
}
constexpr int TS = 32, CHF = TS * 384, NCH = SEQ / TS;
__device__ __forceinline__ float red16(float x) { x += dppf<0xB1>(x); x += dppf<0x4E>(x); x += dppf<0x141>(x); x += dppf<0x140>(x); return x; }
struct LdRegs { u32x4 rc, kc, vc, rp, kp, vp, e, a; };
struct StepRegs { f32x4 r, w, k, q, b; f32x2 v;
    __device__ __forceinline__ void ld(const LAS float* L, int cq, int i0) { r = *(const LAS f32x4*)(L + cq); w = *(const LAS f32x4*)(L + 64 + cq); k = *(const LAS f32x4*)(L + 128 + cq); q = *(const LAS f32x4*)(L + 192 + cq); b = *(const LAS f32x4*)(L + 256 + cq); v = *(const LAS f32x2*)(L + 320 + i0); } };
__device__ void scan_prompt_item(PP p, int item, LAS float* lds) {
    const int tid = tid_opaque(), wid = __builtin_amdgcn_readfirstlane(tid >> 6), lane = tid & 63;
    const int b = item >> 6, h = (item >> 1) & 31, half = item & 1;
    const bf16_t* PROJ = (const bf16_t*)(p->ws + WS_PROJ);
    if (wid >= 4) {
        const int lw = wid - 4, sl = lw * 8 + (lane >> 3), ch0 = (lane & 7) * 8, hc_ = h * 64 + ch0;
        const bf16_t* E = (const bf16_t*)(p->ws + WS_E); const bf16_t* AAA = (const bf16_t*)(p->ws + WS_AAA); float* Cc = (float*)(p->ws + WS_C);
        const bool wr_c = (half == 0) && ((lane & 7) == 0);
        auto load = [&](int c, LdRegs& R) { int hc = hc_; asm volatile("" : "+v"(hc)); const int t = c * TS + sl; const size_t row = (size_t)b * SEQ + t; const bf16_t* pr = PROJ + row * LDP + C_PR + hc;
            R.rc = *(const u32x4*)(pr + PR_R); R.kc = *(const u32x4*)(pr + PR_K); R.vc = *(const u32x4*)(pr + PR_V);
            if (t > 0) { R.rp = *(const u32x4*)(pr + PR_R - LDP); R.kp = *(const u32x4*)(pr + PR_K - LDP); R.vp = *(const u32x4*)(pr + PR_V - LDP); }
            else { R.rp = (u32x4){0u, 0u, 0u, 0u}; R.kp = R.rp; R.vp = R.rp; }
            R.e = *(const u32x4*)(E + row * D + hc); R.a = *(const u32x4*)(AAA + row * D + hc); };
        auto process = [&](int c, const LdRegs& R) { int hc = hc_; asm volatile("" : "+v"(hc)); LAS float* dst = lds + (c & 1) * CHF + sl * 384 + ch0;
            float rc[8], kc[8], vc[8], rp[8], kp[8], vp[8], e[8], a[8], r[8], k[8], v[8], w[8], kk[8], kq[8], bb[8];
            float mu_r[8], mu_k[8], mu_v[8], kks[8], ka[8], rk[8];
            { const float* mb = p->in[I_MU] + hc; const f32x4 a0 = *(const f32x4*)(mb + PR_R), a1 = *(const f32x4*)(mb + PR_R + 4), b0 = *(const f32x4*)(mb + PR_K), b1 = *(const f32x4*)(mb + PR_K + 4), c0 = *(const f32x4*)(mb + PR_V), c1 = *(const f32x4*)(mb + PR_V + 4);
              const f32x4 d0 = *(const f32x4*)(p->in[I_KK] + hc), d1 = *(const f32x4*)(p->in[I_KK] + hc + 4), e0 = *(const f32x4*)(p->in[I_KA] + hc), e1 = *(const f32x4*)(p->in[I_KA] + hc + 4), f0 = *(const f32x4*)(p->in[I_RK] + hc), f1 = *(const f32x4*)(p->in[I_RK] + hc + 4);
#pragma unroll
              for (int q = 0; q < 4; ++q) { mu_r[q] = a0[q]; mu_r[4 + q] = a1[q]; mu_k[q] = b0[q]; mu_k[4 + q] = b1[q]; mu_v[q] = c0[q]; mu_v[4 + q] = c1[q]; kks[q] = d0[q]; kks[4 + q] = d1[q]; ka[q] = e0[q]; ka[4 + q] = e1[q]; rk[q] = f0[q]; rk[4 + q] = f1[q]; } }
            unpack8(R.rc, rc); unpack8(R.kc, kc); unpack8(R.vc, vc); unpack8(R.rp, rp); unpack8(R.kp, kp); unpack8(R.vp, vp); unpack8(R.e, e); unpack8(R.a, a);
            float n2 = 0.f, cc = 0.f;
#pragma unroll
            for (int q = 0; q < 8; ++q) { r[q] = rc[q] + mu_r[q] * (rp[q] - rc[q]); k[q] = kc[q] + mu_k[q] * (kp[q] - kc[q]); v[q] = vc[q] + mu_v[q] * (vp[q] - vc[q]);
                w[q] = __builtin_amdgcn_exp2f(-1.4426950408889634f * e[q]); kk[q] = k[q] * kks[q]; n2 += kk[q] * kk[q];
                kq[q] = k[q] * (1.f + (a[q] - 1.f) * ka[q]); cc += r[q] * kq[q] * rk[q]; }
            n2 = red8(n2); cc = red8(cc); const float inv = 1.f / fmaxf(sqrtf(n2), 1e-12f);
#pragma unroll
            for (int q = 0; q < 8; ++q) { kk[q] *= inv; bb[q] = kk[q] * a[q]; }
            *(LAS f32x4*)(dst) = (f32x4){r[0], r[1], r[2], r[3]}; *(LAS f32x4*)(dst + 4) = (f32x4){r[4], r[5], r[6], r[7]};
            *(LAS f32x4*)(dst + 64) = (f32x4){w[0], w[1], w[2], w[3]}; *(LAS f32x4*)(dst + 68) = (f32x4){w[4], w[5], w[6], w[7]};
            *(LAS f32x4*)(dst + 128) = (f32x4){kq[0], kq[1], kq[2], kq[3]}; *(LAS f32x4*)(dst + 132) = (f32x4){kq[4], kq[5], kq[6], kq[7]};
            *(LAS f32x4*)(dst + 192) = (f32x4){kk[0], kk[1], kk[2], kk[3]}; *(LAS f32x4*)(dst + 196) = (f32x4){kk[4], kk[5], kk[6], kk[7]};
            *(LAS f32x4*)(dst + 256) = (f32x4){bb[0], bb[1], bb[2], bb[3]}; *(LAS f32x4*)(dst + 260) = (f32x4){bb[4], bb[5], bb[6], bb[7]};
            *(LAS f32x4*)(dst + 320) = (f32x4){v[0], v[1], v[2], v[3]}; *(LAS f32x4*)(dst + 324) = (f32x4){v[4], v[5], v[6], v[7]};
            if (wr_c) Cc[((size_t)b * SEQ + c * TS + sl) * 32 + h] = cc; };
        const bool bg = (gridDim.x == 256); const int gidx = blockIdx.x * 4 + lw; LAS float* wl = lds + 2 * CHF + lw * 384;
        auto chunk_head = [&]() { asm volatile("s_waitcnt lgkmcnt(0)" ::: "memory");
            __builtin_amdgcn_s_barrier(); asm volatile("" ::: "memory"); };
        LdRegs R; load(0, R); process(0, R); load(1, R);
        auto chunk_tail = [&](int c) { if (c + 1 < NCH) { process(c + 1, R); if (c + 2 < NCH) load(c + 2, R); } };
        LAS float* tl = lds + 2 * CHF + 4 * 384 + (lw < 3 ? lw : 0) * (32 * 65);
        const int gw3 = blockIdx.x * 3 + lw;
        auto plain = [&](int ca, int cb) {
#pragma unroll 1
            for (int c = ca; c < cb; ++c) { chunk_head(); chunk_tail(c); } };
        auto conv_slot = [&](int c, int k) { const int u = gw3 + BGC_WAVES * k;
            if (bg && lw < 3 && u < BGC_TOTAL) { BgcRegs CR; bgc_load(p, u, CR, lane); chunk_head(); bgc_finish(p, u, CR, tl, lane); chunk_tail(c); }
            else { chunk_head(); chunk_tail(c); } };
#pragma unroll 1
        for (int seg = 0; seg < NCH / 16; ++seg) { const int c0 = seg * 16;
            plain(c0, c0 + 3);
            if (bg) { SmpRegs SR; const int item = gidx + 1024 * seg; smp_load(p, item, SR, lane); chunk_head(); smp_finish(p, item, SR, wl, lane); chunk_tail(c0 + 3); }
            else { chunk_head(); chunk_tail(c0 + 3); }
            plain(c0 + 4, c0 + 7);
            conv_slot(c0 + 7, seg * 2);
            plain(c0 + 8, c0 + 12);
            conv_slot(c0 + 12, seg * 2 + 1);
            plain(c0 + 13, c0 + 16);
        }
    } else {
        __builtin_amdgcn_s_setprio(3);
        const int rp = lane >> 4, cq = (lane & 15) * 4, i0 = half * 32 + wid * 8 + rp * 2;
        bf16_t* Y = (bf16_t*)(p->ws + WS_Y) + (size_t)b * SEQ * D + h * 64 + i0;
        f32x2 S0a = {0.f, 0.f}, S0b = {0.f, 0.f}, S1a = {0.f, 0.f}, S1b = {0.f, 0.f};
        const int lq = lane & 15;
        for (int c = 0; c < NCH; ++c) {
            __syncthreads();
            const LAS float* L = lds + (c & 1) * CHF;
            StepRegs nx; nx.ld(L, cq, i0);
#pragma unroll
            for (int g = 0; g < TS / 16; ++g) {
                float yk = 0.f;
#pragma unroll
                for (int s = 0; s < 16; ++s) {
                    const StepRegs cu = nx; L += 384;
                    if (s < 15 || g + 1 < TS / 16) nx.ld(L, cq, i0);
                    __builtin_amdgcn_sched_barrier(0x477);
                    const f32x4 r4 = cu.r, w4 = cu.w, k4 = cu.k, q4 = cu.q, b4 = cu.b; const f32x2 v2 = cu.v;
                    const f32x2 ra = {r4[0], r4[1]}, rb = {r4[2], r4[3]}, wa = {w4[0], w4[1]}, wb = {w4[2], w4[3]}, ka_ = {k4[0], k4[1]}, kb = {k4[2], k4[3]}, qa = {q4[0], q4[1]}, qb = {q4[2], q4[3]}, ba = {b4[0], b4[1]}, bb_ = {b4[2], b4[3]};
                    f32x2 t0 = __builtin_elementwise_fma(S0b, qb, S0a * qa), t1 = __builtin_elementwise_fma(S1b, qb, S1a * qa);
                    const float sa0 = -red16(t0[0] + t0[1]), sa1 = -red16(t1[0] + t1[1]);
                    const f32x2 sa0v = {sa0, sa0}, sa1v = {sa1, sa1}, v0v = {v2[0], v2[0]}, v1v = {v2[1], v2[1]};
                    S0a = __builtin_elementwise_fma(S0a, wa, __builtin_elementwise_fma(sa0v, ba, v0v * ka_)); S0b = __builtin_elementwise_fma(S0b, wb, __builtin_elementwise_fma(sa0v, bb_, v0v * kb));
                    S1a = __builtin_elementwise_fma(S1a, wa, __builtin_elementwise_fma(sa1v, ba, v1v * ka_)); S1b = __builtin_elementwise_fma(S1b, wb, __builtin_elementwise_fma(sa1v, bb_, v1v * kb));
                    t0 = __builtin_elementwise_fma(S0b, rb, S0a * ra); t1 = __builtin_elementwise_fma(S1b, rb, S1a * ra);
                    const float x0 = t0[0] + t0[1], x1 = t1[0] + t1[1];
                    const bool odd = lane & 1; float u = odd ? x1 : x0; const float vv = odd ? x0 : x1;
                    u += dppf<0xB1>(vv); u += dppf<0x4E>(u); u += dppf<0x124>(u); u += dppf<0x128>(u);
                    yk = ((lq >> 1) == (s & 7)) ? u : yk;
                    if ((s & 7) == 7) Y[(size_t)(c * TS + g * 16 + (s - 7) + (lq >> 1)) * D + (lq & 1)] = f2bf(yk);
                }
            }
        }
        __builtin_amdgcn_s_setprio(0);
        float* so = p->out + O_WKVP + ((size_t)(b * 32 + h) * 64 + i0) * 64 + cq;
        *(f32x4*)so = (f32x4){S0a[0], S0a[1], S0b[0], S0b[1]}; *(f32x4*)(so + 64) = (f32x4){S1a[0], S1a[1], S1b[0], S1b[1]};
    }
    __syncthreads();
}
__device__ void phase4(PP p, LAS unsigned char* lds) {
    REP(4) for (int it = blockIdx.x; it < 256; it += gridDim.x) scan_prompt_item(p, it, (LAS float*)lds);
    const int wid = __builtin_amdgcn_readfirstlane(tid_opaque() >> 6);
    if (gridDim.x != 256) for (int it = blockIdx.x * 8 + wid; it < 4096; it += gridDim.x * 8) scan_sample_item(p, it, (LAS float*)lds + wid * 384);
}

__device__ void phase5(PP p) {
    const int tid = tid_opaque(), lane = tid & 63, gw = blockIdx.x * 8 + (tid >> 6), nw = gridDim.x * 8;
    const bf16_t* PROJ = (const bf16_t*)(p->ws + WS_PROJ); const bf16_t* Y = (const bf16_t*)(p->ws + WS_Y); const float* Cc = (const float*)(p->ws + WS_C); bf16_t* YB = (bf16_t*)(p->ws + WS_YB);
    f32x4 pmu[4][2], pg[4][2], pb[4][2];
#pragma unroll
    for (int q = 0; q < 4; ++q) { const int c0 = q * 512 + lane * 8;
#pragma unroll
        for (int hh = 0; hh < 2; ++hh) { pmu[q][hh] = *(const f32x4*)(p->in[I_MU] + PR_V + c0 + hh * 4); pg[q][hh] = *(const f32x4*)(p->in[I_GNG] + c0 + hh * 4); pb[q][hh] = *(const f32x4*)(p->in[I_GNB] + c0 + hh * 4); } }
    for (int row = gw; row < NTOK_P; row += nw) { const bool first = (row & (SEQ - 1)) == 0; const bf16_t* pr = PROJ + (size_t)row * LDP;
        u32x4 yr[4], vcr[4], vpr[4], zbr[4]; float ccs[4];
#pragma unroll
        for (int q = 0; q < 4; ++q) { const int c0 = q * 512 + lane * 8;
            yr[q] = *(const u32x4*)(Y + (size_t)row * D + c0);
            vcr[q] = *(const u32x4*)(pr + C_PR + PR_V + c0); vpr[q] = first ? (u32x4){0u, 0u, 0u, 0u} : *(const u32x4*)(pr - LDP + C_PR + PR_V + c0);
            zbr[q] = *(const u32x4*)(pr + C_ZB + c0); ccs[q] = Cc[(size_t)row * 32 + (c0 >> 6)]; }
#pragma unroll
        for (int q = 0; q < 4; ++q) { const int c0 = q * 512 + lane * 8; float y[8], vc[8], vp[8], zb[8], f[8];
            unpack8(yr[q], y);
            float s = 0.f;
#pragma unroll
            for (int k = 0; k < 8; ++k) s += y[k];
            const float m = red8(s) * (1.f / 64.f); float s2 = 0.f;
#pragma unroll
            for (int k = 0; k < 8; ++k) { y[k] -= m; s2 += y[k] * y[k]; }
            const float rstd = rsqrtf(red8(s2) * (1.f / 64.f) + 64e-5f);
            unpack8(vcr[q], vc); unpack8(vpr[q], vp); unpack8(zbr[q], zb);
#pragma unroll
            for (int k = 0; k < 8; ++k) { const float v = vc[k] + pmu[q][k >> 2][k & 3] * (vp[k] - vc[k]);
                f[k] = (y[k] * rstd * pg[q][k >> 2][k & 3] + pb[q][k >> 2][k & 3] + ccs[q] * v) * zb[k]; }
            *(u32x4*)(YB + (size_t)row * D + c0) = pack8(f); } }
    for (int idx = blockIdx.x * 512 + tid; idx < NMODROW * SHIFT_W; idx += gridDim.x * 512) { const int rr = idx / SHIFT_W, k = idx % SHIFT_W;
        const size_t srow = rr < 4 ? (size_t)rr * SEQ + SEQ - 1 : (size_t)NTOK_P + rr - 4;
        const float v = bf2f(PROJ[srow * LDP + C_PR + k]);
        if (rr < 4) p->out[O_SHP + (size_t)rr * SHIFT_W + k] = v; else p->out[O_SHS + (size_t)(rr - 4) * SHIFT_W + k] = v; }
}

__device__ void phase9(PP p) {
    const int tid = tid_opaque(), lane = tid & 63, gw = blockIdx.x * 8 + (tid >> 6), nw = gridDim.x * 8; const float* fg = p->in[I_FG];
    const bf16_t* OB = (const bf16_t*)(p->ws + WS_Y);
    f32x4 g[4][2]; u32x4 v[4], vn[4];
#pragma unroll
    for (int i = 0; i < 4; ++i) { g[i][0] = *(const f32x4*)(fg + (lane + 64 * i) * 8); g[i][1] = *(const f32x4*)(fg + (lane + 64 * i) * 8 + 4); }
    if (gw < NTOK) {
#pragma unroll
        for (int i = 0; i < 4; ++i) v[i] = *(const u32x4*)(OB + (size_t)gw * D + (lane + 64 * i) * 8); }
    for (int r = gw; r < NTOK; r += nw) { float* o = p->out + O_Y + (size_t)r * D; const int rn = r + nw;
        if (rn < NTOK) {
#pragma unroll
            for (int i = 0; i < 4; ++i) vn[i] = *(const u32x4*)(OB + (size_t)rn * D + (lane + 64 * i) * 8); }
        float f[4][8]; float ss = 0.f;
#pragma unroll
        for (int i = 0; i < 4; ++i) { unpack8(v[i], f[i]);
#pragma unroll
            for (int q = 0; q < 8; ++q) ss += f[i][q] * f[i][q]; }
        ss = wave_sum(ss); const float rstd = rsqrtf(ss * (1.f / D) + 1e-6f);
#pragma unroll
        for (int i = 0; i < 4; ++i) { const int c = (lane + 64 * i) * 8;
            *(f32x4*)(o + c) = (f32x4){f[i][0], f[i][1], f[i][2], f[i][3]} * rstd * g[i][0]; *(f32x4*)(o + c + 4) = (f32x4){f[i][4], f[i][5], f[i][6], f[i][7]} * rstd * g[i][1]; }
#pragma unroll
        for (int i = 0; i < 4; ++i) v[i] = vn[i];
    }
}

#ifndef DBG_STOP
#define DBG_STOP 99
#endif
__device__ void dbg_dump(PP p) {
    const size_t n = O_CV + 128 * 1024, gt = (size_t)blockIdx.x * 512 + tid_opaque(), gs = (size_t)gridDim.x * 512;
    const bf16_t* w = (const bf16_t*)p->ws;
    for (size_t i = gt; i < n; i += gs) {
        float a = 0.f;
        if (DBG_STOP == 2) { const bf16_t* q = w + WS_PROJ / 2; for (int k = 0; k < 3; ++k) a += bf2f(q[i + (size_t)k * n]); }
        if (DBG_STOP == 1) { const bf16_t* q = w + WS_H / 2; a = bf2f(q[i % ((size_t)MP * D)]); }
        if (DBG_STOP == 0) { const bf16_t* q = w + WS_WTIN / 2; a = bf2f(q[i % ((size_t)LDP * D)]) + bf2f(q[(i + n) % ((size_t)LDP * D)]) + ((const float*)(p->ws + WS_MOD))[i % (NMODROW * 6144)]; }
        if (DBG_STOP == 3) { a = bf2f(w[WS_E / 2 + i % ((size_t)NTOK * D)]) + bf2f(w[WS_AAA / 2 + i % ((size_t)NTOK * D)]) + bf2f(w[WS_YA / 2 + i % ((size_t)NTOK * A_W)]); }
        if (DBG_STOP == 4) { a = bf2f(((const bf16_t*)(p->ws + WS_Y))[i % ((size_t)NTOK_P * D)]) + ((const float*)(p->ws + WS_C))[i % (NTOK_P * 32)]; if (i >= O_WKVP) continue; }
        if (DBG_STOP == 5) { a = bf2f(w[WS_YB / 2 + i % ((size_t)NTOK * D)]); if (i >= O_WKVP) continue; }
        if (DBG_STOP == 7) { a = bf2f(w[WS_MRG / 2 + i % ((size_t)NTOK * D)]); if (i >= O_WKVP) continue; }
        p->out[i] = a;
    }
}

constexpr int NPHASE = 10, LDS_BYTES = 131072 + 16;
__global__ void __launch_bounds__(512) mega(P p_) {
    extern __shared__ __attribute__((aligned(16))) unsigned char shm[];
    LAS unsigned char* lds = (LAS unsigned char*)shm;
    PP p0 = (PP)__builtin_amdgcn_kernarg_segment_ptr();
    const int ph_lo = p0->ph_lo, ph_hi = p0->ph_hi;
    volatile LAS unsigned* st = (volatile LAS unsigned*)(lds + 131072);
    if (threadIdx.x == 0) { st[0] = 0u; st[1] = 0u; st[2] = 0u; st[3] = 0u; }
    __syncthreads();
    const XcdBarrier xb = xcd_barrier_post((unsigned*)(p0->ws + WS_BAR), st);
#ifndef PH_MASK
#define PH_MASK 0x3ff
#endif
#define GSYNC() xcd_barrier(xb)
#define PHASE(n) if (((PH_MASK >> (n)) & 1) && (n) <= DBG_STOP && ph_lo <= (n) && (n) < ph_hi) { if ((n) > ph_lo) GSYNC(); PP p = p0; asm volatile("" : "+s"(p));
#define PHASE_NOSYNC(n) if (((PH_MASK >> (n)) & 1) && (n) <= DBG_STOP && ph_lo <= (n) && (n) < ph_hi) { PP p = p0; asm volatile("" : "+s"(p));
#define PHASE_END }
    PHASE(0) REP(0) { phase0(p, lds); __syncthreads(); } PHASE_END
    PHASE(1) REP(1) phase1(p); PHASE_END
    PHASE(2) REP(2) { pg8::Gemm g{(const bf16_t*)(p->ws + WS_H), (const bf16_t*)(p->ws + WS_WTIN), MP, LDP, D}; pg8::StaticOrder S; S.init(MP, LDP, gridDim.x, blockIdx.x);
        EpiProj E{(bf16_t*)(p->ws + WS_PROJ)}; pg8::gemm_phase(lds, g, S, E); } PHASE_END
#ifdef EXTRA_SYNCS
    for (int i_ = 0; i_ < EXTRA_SYNCS; ++i_) GSYNC();
#endif
    PHASE(3) REP(3) { phase3(p, lds); __syncthreads(); } PHASE_END
    PHASE(4) phase4(p, lds); PHASE_END
    PHASE(5) REP(5) phase5(p); PHASE_END
    PHASE(6) REP(6) { pg8::Gemm g{(const bf16_t*)(p->ws + WS_YA), (const bf16_t*)(p->ws + WS_WTPA), NTOK_P, D, A_W}; pg8::StaticOrder S; S.init(NTOK_P, D, gridDim.x, blockIdx.x);
        EpiMerge<false> E{(bf16_t*)(p->ws + WS_MRG), (const bf16_t*)(p->ws + WS_PROJ) + C_GA}; pg8::gemm_phase(lds, g, S, E);
        bf16_t* mrg = (bf16_t*)(p->ws + WS_MRG) + (size_t)NTOK_P * D; const bf16_t* gp = (const bf16_t*)(p->ws + WS_PROJ) + (size_t)NTOK_P * LDP + C_GA;
        small_gemm((const bf16_t*)(p->ws + WS_YA) + (size_t)NTOK_P * A_W, (const bf16_t*)(p->ws + WS_WTPA), A_W, (LAS float*)lds, [&](const f32x4 acc, int r, int c) {
            const u32x2 g2 = *(const u32x2*)(gp + (size_t)r * LDP + c); u32x2 o; o[0] = cvt_pk_bf16(acc[0] * bflo(g2[0]), acc[1] * bfhi(g2[0])); o[1] = cvt_pk_bf16(acc[2] * bflo(g2[1]), acc[3] * bfhi(g2[1]));
            *(u32x2*)(mrg + (size_t)r * D + c) = o; }); } PHASE_END
    PHASE_NOSYNC(7) { pg8::Gemm g{(const bf16_t*)(p->ws + WS_YB), (const bf16_t*)(p->ws + WS_WTPB), NTOK_P, D, B_W}; pg8::StaticOrder S; S.init(NTOK_P, D, gridDim.x, blockIdx.x);
        EpiMerge<true> E{(bf16_t*)(p->ws + WS_MRG), (const bf16_t*)(p->ws + WS_PROJ) + C_GB}; pg8::gemm_phase(lds, g, S, E);
        bf16_t* mrg = (bf16_t*)(p->ws + WS_MRG) + (size_t)NTOK_P * D; const bf16_t* gp = (const bf16_t*)(p->ws + WS_PROJ) + (size_t)NTOK_P * LDP + C_GB;
        small_gemm((const bf16_t*)(p->ws + WS_YB) + (size_t)NTOK_P * B_W, (const bf16_t*)(p->ws + WS_WTPB), B_W, (LAS float*)lds, [&](const f32x4 acc, int r, int c) {
            const u32x2 g2 = *(const u32x2*)(gp + (size_t)r * LDP + c), m2 = *(const u32x2*)(mrg + (size_t)r * D + c); u32x2 o;
            o[0] = cvt_pk_bf16(bflo(m2[0]) + acc[0] * bflo(g2[0]), bfhi(m2[0]) + acc[1] * bfhi(g2[0])); o[1] = cvt_pk_bf16(bflo(m2[1]) + acc[2] * bflo(g2[1]), bfhi(m2[1]) + acc[3] * bfhi(g2[1]));
            *(u32x2*)(mrg + (size_t)r * D + c) = o; }); } PHASE_END
    PHASE(8) REP(8) { pg8::Gemm g{(const bf16_t*)(p->ws + WS_MRG), (const bf16_t*)(p->ws + WS_WTOUT), NTOK_P, D, D}; pg8::StaticOrder S; S.init(NTOK_P, D, gridDim.x, blockIdx.x);
        EpiOut E{(bf16_t*)(p->ws + WS_Y), p->in[I_XP], p->in[I_XS], (const float*)(p->ws + WS_MOD)}; pg8::gemm_phase(lds, g, S, E);
        bf16_t* os = (bf16_t*)(p->ws + WS_Y) + (size_t)NTOK_P * D; const float* xs = p->in[I_XS]; const float* gate = (const float*)(p->ws + WS_MOD) + (size_t)4 * 6144 + 4096;
        small_gemm((const bf16_t*)(p->ws + WS_MRG) + (size_t)NTOK_P * D, (const bf16_t*)(p->ws + WS_WTOUT), D, (LAS float*)lds, [&](const f32x4 acc, int r, int c) {
            const f32x4 o = *(const f32x4*)(xs + (size_t)r * D + c) + *(const f32x4*)(gate + (size_t)r * 6144 + c) * acc; u32x2 ob; ob[0] = cvt_pk_bf16(o[0], o[1]); ob[1] = cvt_pk_bf16(o[2], o[3]);
            *(u32x2*)(os + (size_t)r * D + c) = ob; }); } PHASE_END
    PHASE(9) phase9(p); PHASE_END
    if (DBG_STOP < 9) { GSYNC(); PP p = p0; asm volatile("" : "+s"(p)); dbg_dump(p); }
}

extern "C" void kernel_launch(void* const* d_in, const int* in_sizes, int n_in, void* d_out, int out_size, void* d_ws, size_t ws_size, hipStream_t stream) {
    static int grid_blocks = 0;
    if (grid_blocks == 0) {
        if (n_in != 28 || ws_size < WS_END) { fprintf(stderr, "kernel_launch: unexpected n_in %d or ws_size %zu (need %zu)\n", n_in, ws_size, (size_t)WS_END); grid_blocks = -1; return; }
        int dev = 0, cus = 0, per_cu = 0;
        (void)hipGetDevice(&dev);
        (void)hipDeviceGetAttribute(&cus, hipDeviceAttributeMultiprocessorCount, dev);
        if (hipFuncSetAttribute((const void*)mega, hipFuncAttributeMaxDynamicSharedMemorySize, LDS_BYTES) != hipSuccess) { fprintf(stderr, "kernel_launch: hipFuncSetAttribute failed\n"); grid_blocks = -1; return; }
        if (hipOccupancyMaxActiveBlocksPerMultiprocessor(&per_cu, (const void*)mega, 512, LDS_BYTES) != hipSuccess || per_cu < 1) { fprintf(stderr, "kernel_launch: occupancy query failed (%d)\n", per_cu); grid_blocks = -1; return; }
        grid_blocks = cus * per_cu;
    }
    if (grid_blocks < 0) return;
    if (hipMemsetAsync((unsigned char*)d_ws + WS_BAR, 0, XCD_BAR_WORDS_C * 4, stream) != hipSuccess) { fprintf(stderr, "kernel_launch: memset of barrier words failed\n"); return; }
    P p{};
    for (int i = 0; i < 28; ++i) p.in[i] = (const float*)d_in[i];
    p.out = (float*)d_out; p.ws = (unsigned char*)d_ws;
#if N_LAUNCH_PER_PHASE
    for (int ph = 0; ph < NPHASE; ++ph) { p.ph_lo = ph; p.ph_hi = ph + 1; void* args[] = {&p};
        hipError_t e = hipLaunchCooperativeKernel((const void*)mega, dim3(grid_blocks), dim3(512), args, LDS_BYTES, stream);
        if (e != hipSuccess) { fprintf(stderr, "cooperative launch failed: %s (grid %d)\n", hipGetErrorString(e), grid_blocks); return; } }
#else
    p.ph_lo = 0; p.ph_hi = NPHASE; void* args[] = {&p};
    hipError_t e = hipLaunchCooperativeKernel((const void*)mega, dim3(grid_blocks), dim3(512), args, LDS_BYTES, stream);
    if (e != hipSuccess) fprintf(stderr, "cooperative launch failed: %s (grid %d)\n", hipGetErrorString(e), grid_blocks);
#endif
}
```
